# Optimizing an MI355X kernel written in HIP

```python
import math
import jax, jax.numpy as jnp
from jax import lax
import numpy as np

D_MODEL = 1024
BATCH = 16
SEQ = 2048
DEPTH = 1

CHUNK = 64
N_META = 16
Q_BLOCK = 128
SB_HEADS = 8
SB_HEAD_DIM = 64
SB_WIDTH = SB_HEADS * SB_HEAD_DIM
MLA_HEADS = 8
MLA_Q_LORA = 384
MLA_KV_LORA = 256
MLA_NOPE = 64
MLA_ROPE = 32
MLA_V = 64
MLA_WIDTH = MLA_HEADS * MLA_V
ROPE_THETA = 10000.0
N_BRANCH = 2
IN_COLS = 3 * SB_WIDTH + MLA_Q_LORA + MLA_KV_LORA + MLA_ROPE + N_BRANCH * D_MODEL
D_FF = 2816
EPS = 1e-6
NEG_INF = -1e30
PAD_CHUNK_ID = 2 ** 30

kernel_name = "hybrid_sb_mla_macaron_block"


def rmsnorm(x, g):
    xf = x.astype(jnp.float32)
    y = xf * lax.rsqrt(jnp.mean(xf * xf, axis=-1, keepdims=True) + EPS)
    return (y * g.astype(jnp.float32)).astype(x.dtype)


def swiglu(h, w_gate, w_up, w_down):
    return (jax.nn.silu(h @ w_gate) * (h @ w_up)) @ w_down


def rope(x, pos):
    half = x.shape[-1] // 2
    inv = ROPE_THETA ** (-jnp.arange(half, dtype=jnp.float32) / half)
    ang = pos[:, None] * inv[None, :]
    cos = jnp.cos(ang).astype(x.dtype)
    sin = jnp.sin(ang).astype(x.dtype)
    x1, x2 = x[..., :half], x[..., half:]
    return jnp.concatenate([x1 * cos - x2 * sin, x1 * sin + x2 * cos], axis=-1)


def to_heads(t, n_heads):
    b, l, _ = t.shape
    return t.reshape(b, l, n_heads, -1).transpose(0, 2, 1, 3)


def from_heads(t):
    b, h, l, d = t.shape
    return t.transpose(0, 2, 1, 3).reshape(b, l, h * d)


def chunk_end(pos):
    if pos < N_META:
        return N_META
    return N_META + ((pos - N_META) // CHUNK + 1) * CHUNK


def stick_breaking_attention(q, k, v):
    lp, d = q.shape[2], q.shape[3]
    scale = d ** -0.5
    outs = []
    for blk in range(lp // Q_BLOCK):
        q0, q1 = blk * Q_BLOCK, (blk + 1) * Q_BLOCK
        z = jnp.einsum('bhtd,bhsd->bhts', q[:, :, q0:q1], k[:, :, :q1]).astype(jnp.float32) * scale
        strict = jnp.arange(q1)[None, :] < jnp.arange(q0, q1)[:, None]
        log_1m = jnp.where(strict, jax.nn.log_sigmoid(-z), 0.0)
        csum = jnp.cumsum(log_1m, axis=-1)
        log_a = jax.nn.log_sigmoid(z) + csum[..., -1:] - csum
        a = jnp.where(strict, jnp.exp(log_a), 0.0)
        outs.append(jnp.einsum('bhts,bhsd->bhtd', a.astype(v.dtype), v[:, :, :q1]))
    return jnp.concatenate(outs, axis=2)


def latent_attention(q_nope, q_rope, k_nope, k_rope, v, cid):
    lp = q_nope.shape[2]
    scale = (MLA_NOPE + MLA_ROPE) ** -0.5
    outs = []
    for blk in range(lp // Q_BLOCK):
        q0, q1 = blk * Q_BLOCK, (blk + 1) * Q_BLOCK
        kend = min(lp, chunk_end(q1 - 1))
        s = (jnp.einsum('bhtd,bhsd->bhts', q_nope[:, :, q0:q1], k_nope[:, :, :kend])
             + jnp.einsum('bhtd,bsd->bhts', q_rope[:, :, q0:q1], k_rope[:, :kend]))
        s = s.astype(jnp.float32) * scale
        mask = cid[None, :kend] <= cid[q0:q1, None]
        p = jax.nn.softmax(jnp.where(mask, s, NEG_INF), axis=-1)
        outs.append(jnp.einsum('bhts,bhsd->bhtd', p.astype(v.dtype), v[:, :, :kend]))
    return jnp.concatenate(outs, axis=2)


def hybrid_mixer(u, w_in, b_gate, q_norm_g, w_uq, kv_norm_g, w_ukv, w_sb_o, w_mla_o, w_out):
    bsz, l, _ = u.shape
    lp = -(-l // Q_BLOCK) * Q_BLOCK
    up = jnp.pad(u, ((0, 0), (0, lp - l), (0, 0)))
    proj = up @ w_in
    sizes = [SB_WIDTH, SB_WIDTH, SB_WIDTH, MLA_Q_LORA, MLA_KV_LORA, MLA_ROPE, N_BRANCH * D_MODEL]
    idx = np.cumsum(sizes)[:-1].tolist()
    sb_q, sb_k, sb_v, c_q, c_kv, k_r, gate_pre = jnp.split(proj, idx, axis=-1)

    pos = jnp.arange(lp)
    cid = jnp.where(pos < N_META, 0, 1 + (pos - N_META) // CHUNK)
    cid = jnp.where(pos < l, cid, PAD_CHUNK_ID)
    posf = pos.astype(jnp.float32)

    y_sb = stick_breaking_attention(to_heads(sb_q, SB_HEADS), to_heads(sb_k, SB_HEADS),
                                    to_heads(sb_v, SB_HEADS))
    y_sb = from_heads(y_sb) @ w_sb_o

    q = jnp.einsum('bld,dhe->bhle', rmsnorm(c_q, q_norm_g), w_uq)
    q_nope, q_rope = q[..., :MLA_NOPE], rope(q[..., MLA_NOPE:], posf)
    kv = jnp.einsum('bld,dhe->bhle', rmsnorm(c_kv, kv_norm_g), w_ukv)
    k_nope, v = kv[..., :MLA_NOPE], kv[..., MLA_NOPE:]
    k_rope = rope(k_r, posf)
    y_mla = latent_attention(q_nope, q_rope, k_nope, k_rope, v, cid)
    y_mla = from_heads(y_mla) @ w_mla_o

    g = jax.nn.sigmoid(gate_pre + b_gate)
    g_sb, g_mla = g[..., :D_MODEL], g[..., D_MODEL:]
    out = (g_sb * y_sb + g_mla * y_mla) @ w_out
    return out[:, :l]


def setup_inputs(seed: int = 0) -> dict:
    key = jax.random.key(seed)
    ks = jax.random.split(key, 24)

    def w(k, shape, fan_in):
        return jax.random.normal(k, shape, jnp.float32) * fan_in ** -0.5

    def gain(k, n):
        return 1.0 + 0.02 * jax.random.normal(k, (DEPTH, n), jnp.float32)

    return {
        "x": jax.random.normal(ks[0], (BATCH, SEQ, D_MODEL), jnp.float32),
        "meta_tokens": jax.random.normal(ks[1], (N_META, D_MODEL), jnp.float32),
        "ffn1_pre_g": gain(ks[2], D_MODEL),
        "ffn1_w_gate": w(ks[3], (DEPTH, D_MODEL, D_FF), D_MODEL),
        "ffn1_w_up": w(ks[4], (DEPTH, D_MODEL, D_FF), D_MODEL),
        "ffn1_w_down": w(ks[5], (DEPTH, D_FF, D_MODEL), D_FF),
        "ffn1_post_g": gain(ks[6], D_MODEL),
        "mix_pre_g": gain(ks[7], D_MODEL),
        "w_in": w(ks[8], (DEPTH, D_MODEL, IN_COLS), D_MODEL),
        "b_gate": 0.02 * jax.random.normal(ks[9], (DEPTH, N_BRANCH * D_MODEL), jnp.float32),
        "q_norm_g": gain(ks[10], MLA_Q_LORA),
        "w_uq": w(ks[11], (DEPTH, MLA_Q_LORA, MLA_HEADS, MLA_NOPE + MLA_ROPE), MLA_Q_LORA),
        "kv_norm_g": gain(ks[12], MLA_KV_LORA),
        "w_ukv": w(ks[13], (DEPTH, MLA_KV_LORA, MLA_HEADS, MLA_NOPE + MLA_V), MLA_KV_LORA),
        "w_sb_o": w(ks[14], (DEPTH, SB_WIDTH, D_MODEL), SB_WIDTH),
        "w_mla_o": w(ks[15], (DEPTH, MLA_WIDTH, D_MODEL), MLA_WIDTH),
        "w_out": w(ks[16], (DEPTH, D_MODEL, D_MODEL), D_MODEL),
        "mix_post_g": gain(ks[17], D_MODEL),
        "ffn2_pre_g": gain(ks[18], D_MODEL),
        "ffn2_w_gate": w(ks[19], (DEPTH, D_MODEL, D_FF), D_MODEL),
        "ffn2_w_up": w(ks[20], (DEPTH, D_MODEL, D_FF), D_MODEL),
        "ffn2_w_down": w(ks[21], (DEPTH, D_FF, D_MODEL), D_FF),
        "ffn2_post_g": gain(ks[22], D_MODEL),
    }


def reference(x, meta_tokens, ffn1_pre_g, ffn1_w_gate, ffn1_w_up, ffn1_w_down, ffn1_post_g,
              mix_pre_g, w_in, b_gate, q_norm_g, w_uq, kv_norm_g, w_ukv, w_sb_o, w_mla_o,
              w_out, mix_post_g, ffn2_pre_g, ffn2_w_gate, ffn2_w_up, ffn2_w_down, ffn2_post_g):
    bsz = x.shape[0]
    meta = jnp.broadcast_to(meta_tokens[None].astype(x.dtype), (bsz, N_META, x.shape[-1]))
    h = jnp.concatenate([meta, x], axis=1)
    for l in range(DEPTH):
        f = swiglu(rmsnorm(h, ffn1_pre_g[l]), ffn1_w_gate[l], ffn1_w_up[l], ffn1_w_down[l])
        h = h + 0.5 * rmsnorm(f, ffn1_post_g[l])
        m = hybrid_mixer(rmsnorm(h, mix_pre_g[l]), w_in[l], b_gate[l], q_norm_g[l], w_uq[l],
                         kv_norm_g[l], w_ukv[l], w_sb_o[l], w_mla_o[l], w_out[l])
        h = h + rmsnorm(m, mix_post_g[l])
        f = swiglu(rmsnorm(h, ffn2_pre_g[l]), ffn2_w_gate[l], ffn2_w_up[l], ffn2_w_down[l])
        h = h + 0.5 * rmsnorm(f, ffn2_post_g[l])
    return h[:, N_META:]
```

```cpp
#include <hip/hip_runtime.h>
#include <hip/hip_cooperative_groups.h>
#include <cstdio>
#include <cstdint>
namespace cg = cooperative_groups;

#ifndef ONE_LAUNCH
#define ONE_LAUNCH 1
#endif

#define LAS __attribute__((address_space(3)))
typedef unsigned short bf16_t;
typedef short bf16x8 __attribute__((ext_vector_type(8)));
typedef short s16x4 __attribute__((ext_vector_type(4)));
typedef float f32x4 __attribute__((ext_vector_type(4)));
typedef float f32x16 __attribute__((ext_vector_type(16)));
typedef unsigned u32x4 __attribute__((ext_vector_type(4)));
typedef unsigned u32x2 __attribute__((ext_vector_type(2)));

constexpr int D = 1024, FF = 2816, NB = 16, SEQ = 2048, NMETA = 16;
constexpr int MX = NB * SEQ;
constexpr int MT = MX + 256;
constexpr int PROJ_LD = 3840;
constexpr int C_SBQ = 0, C_SBK = 512, C_CQ = 1024, C_CKV = 1408, C_KR = 1664, C_GATE = 1792;
constexpr int LDVT = MT;
constexpr float EPS = 1e-6f;
constexpr float LOG2E = 1.4426950408889634f;
constexpr float SB_C = 0.125f * LOG2E;
constexpr float MLA_QSCALE = 0.10206207261596577f * LOG2E;

constexpr size_t MiB = 1u << 20;
constexpr size_t WS_CTL = 0;
constexpr size_t WS_SS = 1 * MiB;
constexpr size_t WS_TAB = 2 * MiB;
constexpr size_t WS_HM = 3 * MiB;
constexpr size_t WS_W = 4 * MiB;
constexpr size_t W_GU1 = WS_W, W_D1 = W_GU1 + (size_t)5632 * 1024 * 2, W_GU2 = W_D1 + (size_t)1024 * 2816 * 2, W_D2 = W_GU2 + (size_t)5632 * 1024 * 2;
constexpr size_t W_IN = W_D2 + (size_t)1024 * 2816 * 2, W_SBV = W_IN + (size_t)3840 * 1024 * 2, W_UQ = W_SBV + (size_t)512 * 1024 * 2;
constexpr size_t W_UKVK = W_UQ + (size_t)768 * 384 * 2, W_UKVV = W_UKVK + (size_t)512 * 256 * 2, W_SBO = W_UKVV + (size_t)512 * 256 * 2;
constexpr size_t W_MLAO = W_SBO + (size_t)1024 * 512 * 2, W_OUT = W_MLAO + (size_t)1024 * 512 * 2, W_END = W_OUT + (size_t)1024 * 1024 * 2;
static_assert(W_END <= 52 * MiB, "weights");
constexpr size_t WS_A = 52 * MiB;
constexpr size_t RSZ = (size_t)MT * 1024 * 2;
constexpr size_t WS_B = WS_A + RSZ;
constexpr size_t WS_C = WS_B + RSZ;
constexpr size_t WS_YM = WS_C + (size_t)MT * 768 * 2;
constexpr size_t WS_P = WS_YM + (size_t)MT * 512 * 2;
constexpr size_t WS_END = WS_P + (size_t)MT * PROJ_LD * 2;
static_assert(WS_END <= 512 * MiB, "workspace");

struct Params {
    const float* in[23];
    float* out;
    unsigned char* ws;
    float inv_freq[16];
    int ph_lo, ph_hi;
};

__device__ __forceinline__ unsigned cvt_pk_bf16(float lo, float hi) { unsigned r; asm volatile("v_cvt_pk_bf16_f32 %0, %1, %2" : "=v"(r) : "v"(lo), "v"(hi)); return r; }
__device__ __forceinline__ float bf_lo(unsigned u) { return __uint_as_float(u << 16); }
__device__ __forceinline__ float bf_hi(unsigned u) { return __uint_as_float(u & 0xffff0000u); }
__device__ __forceinline__ float fexp2(float x) { return __builtin_amdgcn_exp2f(x); }
__device__ __forceinline__ float frcp(float x) { return __builtin_amdgcn_rcpf(x); }
__device__ __forceinline__ float sigmoidf_(float x) { return frcp(1.0f + fexp2(-x * LOG2E)); }
__device__ __forceinline__ float wave_sum(float v) {
#pragma unroll
    for (int o = 1; o < 64; o <<= 1) v += __shfl_xor(v, o);
    return v;
}
__device__ __forceinline__ int row_pos(int row) { return row < MX ? NMETA + (row & (SEQ - 1)) : ((row - MX) & 15); }

namespace pg8 {
constexpr int BM = 256, BK = 64, HALF = 128, HTB = HALF * BK * 2, STAGE_BYTES = 8 * HTB, NXCD = 8, WGM = 8;
__device__ __forceinline__ int lds_byte(int r, int c) { const int st = (r >> 4) * 2 + (c >> 5), rr = r & 15, cc = c & 31, ob = rr * 64 + cc * 2; return st * 1024 + (ob ^ (((ob >> 9) & 1) << 5)); }
__device__ __forceinline__ void stage_rc(int b, int& R, int& C) { const int st = b / 1024, sb = b % 1024, swz = sb ^ (((sb >> 9) & 1) << 5); R = (st >> 1) * 16 + swz / 64; C = (st & 1) * 32 + (swz % 64) / 2; }
__device__ __forceinline__ int perm32(int rho) { const int n = rho >> 4, i = rho & 15; return 8 * (i >> 2) + 4 * n + (i & 3); }

struct Unit { int pm, pn; };
struct Gemm { const bf16_t* A; const bf16_t* Bt; int M, N, K, lda, ldb; };

struct StaticOrder {
    int nM, nN, nwg, G, c;
    __device__ void init(int M, int N, int G_, int c_) { nM = M / BM; nN = N / BM; nwg = nM * nN; G = G_; c = c_; }
    __device__ bool next(int i, Unit& u) const {
        const long L = (long)i * G + c; if (L >= nwg) return false;
        int wgid = (int)L; { const int q = nwg / NXCD, r = nwg % NXCD, xcd = wgid % NXCD, off = wgid / NXCD; wgid = (xcd < r ? xcd * (q + 1) : r * (q + 1) + (xcd - r) * q) + off; }
        const int nig = WGM * nN, gid = wgid / nig, fm = gid * WGM, gsz = (nM - fm) < WGM ? (nM - fm) : WGM;
        u.pm = fm + ((wgid % nig) % gsz); u.pn = (wgid % nig) / gsz; return true;
    }
};

template <class Epi>
__device__ __forceinline__ void gemm_phase(LAS unsigned char* lds, const Gemm g, const StaticOrder& S, const Epi& E) {
    const int tid = threadIdx.x, wid = __builtin_amdgcn_readfirstlane(tid >> 6), lane = tid & 63, wr = wid >> 2, wc = wid & 3, fr = lane & 15, fq = lane >> 4;
    const int K = g.K, nt = K / BK;
    unsigned voffA[2], voffB[2];
#pragma unroll
    for (int i = 0; i < 2; ++i) { int R, C; stage_rc(tid * 16 + i * 8192, R, C); const int Rb = Epi::PERM ? ((R & ~31) + perm32(R & 31)) : R;
        voffA[i] = (unsigned)(R * g.lda + C) * 2u; voffB[i] = (unsigned)(Rb * g.ldb + C) * 2u; }
    const size_t kstep = (size_t)(BK * 2);
    const size_t hA = (size_t)HALF * g.lda * 2, hB = (size_t)HALF * g.ldb * 2, tA = 2 * hA, tB = 2 * hB;
    const unsigned ldsw = (unsigned)wid * 1024u;
    const int aoff = lds_byte(wr * 64 + fr, fq * 8), boff = lds_byte(wc * 32 + fr, fq * 8);
#define PG8_SA(b, h) (((b) * 2 + (h)) * HTB)
#define PG8_SB(b, h) ((4 + (b) * 2 + (h)) * HTB)
#define PG8_STAGE(bufoff, gbase, voff) do { _Pragma("unroll") for (int _i = 0; _i < 2; ++_i) \
        __builtin_amdgcn_global_load_lds((const unsigned*)((const char*)(gbase) + (voff)[_i]), (LAS unsigned*)(lds + (bufoff) + ldsw + _i * 8192), 16, 0, 0); } while (0)
#define PG8_LDA(dst, b, h) do { _Pragma("unroll") for (int m = 0; m < 4; ++m) _Pragma("unroll") for (int k = 0; k < 2; ++k) dst[m][k] = *(const LAS bf16x8*)(lds + PG8_SA(b, h) + aoff + m * 2048 + k * 1024); } while (0)
#define PG8_LDB(dst, b, h) do { _Pragma("unroll") for (int n = 0; n < 2; ++n) _Pragma("unroll") for (int k = 0; k < 2; ++k) dst[n][k] = *(const LAS bf16x8*)(lds + PG8_SB(b, h) + boff + n * 2048 + k * 1024); } while (0)
#define PG8_MMA(ai, bj, At, Bt) do { __builtin_amdgcn_s_setprio(1); _Pragma("unroll") for (int m = 0; m < 4; ++m) _Pragma("unroll") for (int n = 0; n < 2; ++n) _Pragma("unroll") for (int k = 0; k < 2; ++k) \
        acc[ai][bj][m][n] = __builtin_amdgcn_mfma_f32_16x16x32_bf16(Bt[n][k], At[m][k], acc[ai][bj][m][n], 0, 0, 0); __builtin_amdgcn_s_setprio(0); } while (0)
#define PG8_WAIT_V(n) asm volatile("s_waitcnt vmcnt(" #n ")" ::: "memory")
#define PG8_WAIT_L(n) asm volatile("s_waitcnt lgkmcnt(" #n ")" ::: "memory")
#define PG8_BAR __builtin_amdgcn_s_barrier()
#define PG8_SCHED __builtin_amdgcn_sched_barrier(0)
    Unit cur, nxt; int ui = 0;
    if (!S.next(0, cur)) return;
    f32x4 acc[2][2][4][2];
#pragma unroll
    for (int a = 0; a < 2; ++a)
#pragma unroll
        for (int b = 0; b < 2; ++b)
#pragma unroll
            for (int m = 0; m < 4; ++m)
#pragma unroll
                for (int n = 0; n < 2; ++n) acc[a][b][m][n] = (f32x4){0.f, 0.f, 0.f, 0.f};
    bf16x8 At[4][2], B0[2][2], B1[2][2];
    const char* cA = (const char*)g.A + (size_t)cur.pm * tA; const char* cB = (const char*)g.Bt + (size_t)cur.pn * tB;
    PG8_STAGE(PG8_SB(0, 0), cB, voffB); PG8_STAGE(PG8_SB(0, 1), cB + hB, voffB); PG8_STAGE(PG8_SA(0, 0), cA, voffA); PG8_STAGE(PG8_SA(0, 1), cA + hA, voffA);
    if (wr == 1) PG8_BAR;
    PG8_WAIT_V(2); PG8_BAR;
    PG8_STAGE(PG8_SB(1, 0), cB + kstep, voffB); PG8_STAGE(PG8_SA(1, 0), cA + kstep, voffA); PG8_STAGE(PG8_SB(1, 1), cB + hB + kstep, voffB);
    PG8_WAIT_V(6); PG8_BAR;
    for (;;) {
        const bool has_next = S.next(ui + 1, nxt);
        const char* nA = has_next ? (const char*)g.A + (size_t)nxt.pm * tA : cA; const char* nB = has_next ? (const char*)g.Bt + (size_t)nxt.pn * tB : cB;
        for (int t = 0; t < nt; t += 2) {
            const bool last = (t == nt - 2);
            const char* a1 = cA + (size_t)(t + 1) * kstep;
            const char* a2 = last ? nA : cA + (size_t)(t + 2) * kstep; const char* b2 = last ? nB : cB + (size_t)(t + 2) * kstep;
            const char* a3 = a2 + kstep; const char* b3 = b2 + kstep;
            PG8_LDB(B0, 0, 0); PG8_LDB(B1, 0, 1); PG8_SCHED; PG8_LDA(At, 0, 0); PG8_STAGE(PG8_SA(1, 1), a1 + hA, voffA);
            PG8_WAIT_V(8); PG8_WAIT_L(0); PG8_BAR; PG8_MMA(0, 0, At, B0); PG8_MMA(0, 1, At, B1); PG8_BAR; PG8_SCHED;
            PG8_LDA(At, 0, 1); PG8_STAGE(PG8_SB(0, 0), b2, voffB); PG8_STAGE(PG8_SB(0, 1), b2 + hB, voffB); PG8_STAGE(PG8_SA(0, 0), a2, voffA);
            PG8_WAIT_V(8); PG8_WAIT_L(0); PG8_BAR; PG8_MMA(1, 0, At, B0); PG8_MMA(1, 1, At, B1); PG8_BAR; PG8_SCHED;
            PG8_LDB(B0, 1, 0); PG8_LDB(B1, 1, 1); PG8_SCHED; PG8_LDA(At, 1, 0); PG8_STAGE(PG8_SA(0, 1), a2 + hA, voffA);
            PG8_WAIT_V(8); PG8_WAIT_L(0); PG8_BAR; PG8_MMA(0, 0, At, B0); PG8_MMA(0, 1, At, B1); PG8_BAR; PG8_SCHED;
            PG8_LDA(At, 1, 1); PG8_STAGE(PG8_SB(1, 0), b3, voffB); PG8_STAGE(PG8_SB(1, 1), b3 + hB, voffB); PG8_STAGE(PG8_SA(1, 0), a3, voffA);
            PG8_WAIT_V(8); PG8_WAIT_L(0); PG8_BAR; PG8_MMA(1, 0, At, B0); PG8_MMA(1, 1, At, B1); PG8_BAR; PG8_SCHED;
        }
        if (wr == 0) PG8_BAR;
        E(acc, cur, wr, wc, fr, fq);
        if (!has_next) break;
#pragma unroll
        for (int a = 0; a < 2; ++a)
#pragma unroll
            for (int b = 0; b < 2; ++b)
#pragma unroll
                for (int m = 0; m < 4; ++m)
#pragma unroll
                    for (int n = 0; n < 2; ++n) acc[a][b][m][n] = (f32x4){0.f, 0.f, 0.f, 0.f};
        cur = nxt; cA = nA; cB = nB; ++ui;
        if (wr == 1) PG8_BAR;
    }
    PG8_WAIT_V(0);
    PG8_BAR;
#undef PG8_SA
#undef PG8_SB
#undef PG8_STAGE
#undef PG8_LDA
#undef PG8_LDB
#undef PG8_MMA
#undef PG8_WAIT_V
#undef PG8_WAIT_L
#undef PG8_BAR
#undef PG8_SCHED
}

typedef const f32x4 (&AccRef)[2][2][4][2];
__device__ __forceinline__ u32x4 pack8(const f32x4 v0, const f32x4 v1) { u32x4 w; w.x = cvt_pk_bf16(v0[0], v0[1]); w.y = cvt_pk_bf16(v0[2], v0[3]); w.z = cvt_pk_bf16(v1[0], v1[1]); w.w = cvt_pk_bf16(v1[2], v1[3]); return w; }
__device__ __forceinline__ float dot8(const f32x4 a, const f32x4 b) { return (a[0] * a[0] + a[1] * a[1]) + (a[2] * a[2] + a[3] * a[3]) + (b[0] * b[0] + b[1] * b[1]) + (b[2] * b[2] + b[3] * b[3]); }

struct EpiSwiglu { static constexpr bool PERM = true; bf16_t* O;
    __device__ __forceinline__ void operator()(AccRef acc, const Unit& u, int wr, int wc, int fr, int fq) const {
        const int row0 = u.pm * BM + wr * 64 + fr, col0 = u.pn * 128 + wc * 32 + 8 * fq;
#pragma unroll
        for (int ai = 0; ai < 2; ++ai)
#pragma unroll
            for (int m = 0; m < 4; ++m) { bf16_t* p = O + (size_t)(row0 + ai * HALF + m * 16) * FF + col0;
                f32x4 h0, h1;
#pragma unroll
                for (int j = 0; j < 4; ++j) { const float g0 = acc[ai][0][m][0][j], g1 = acc[ai][0][m][1][j];
                    h0[j] = g0 * sigmoidf_(g0) * acc[ai][1][m][0][j]; h1[j] = g1 * sigmoidf_(g1) * acc[ai][1][m][1][j]; }
                *(u32x4*)p = pack8(h0, h1); }
    }
};
struct EpiStoreSS { static constexpr bool PERM = true; bf16_t* O; int ldc; float* SS;
    __device__ __forceinline__ void operator()(AccRef acc, const Unit& u, int wr, int wc, int fr, int fq) const {
        const int row0 = u.pm * BM + wr * 64 + fr, col0 = u.pn * BM + wc * 32 + 8 * fq;
#pragma unroll
        for (int ai = 0; ai < 2; ++ai)
#pragma unroll
            for (int m = 0; m < 4; ++m) { const int row = row0 + ai * HALF + m * 16; bf16_t* p = O + (size_t)row * ldc + col0; float s = 0.f;
#pragma unroll
                for (int bj = 0; bj < 2; ++bj) { s += dot8(acc[ai][bj][m][0], acc[ai][bj][m][1]); *(u32x4*)(p + bj * HALF) = pack8(acc[ai][bj][m][0], acc[ai][bj][m][1]); }
                if (SS) { s += __shfl_xor(s, 16); s += __shfl_xor(s, 32); if (fq == 0) unsafeAtomicAdd(SS + row, s); } }
    }
};
template <int MODE> struct EpiScaled { static constexpr bool PERM = true; bf16_t* O; int ldc; const float* SS; float inv_n; float mul;
    __device__ __forceinline__ void operator()(AccRef acc, const Unit& u, int wr, int wc, int fr, int fq) const {
        const int row0 = u.pm * BM + wr * 64 + fr, col0 = u.pn * BM + wc * 32 + 8 * fq;
#pragma unroll
        for (int ai = 0; ai < 2; ++ai)
#pragma unroll
            for (int m = 0; m < 4; ++m) { const int row = row0 + ai * HALF + m * 16; bf16_t* p = O + (size_t)row * ldc + col0;
                float rs = 1.f; if (MODE == 1) rs = __builtin_amdgcn_rsqf(SS[row] * inv_n + EPS) * mul;
#pragma unroll
                for (int bj = 0; bj < 2; ++bj) { f32x4 v0 = acc[ai][bj][m][0], v1 = acc[ai][bj][m][1];
                    if (MODE == 1) { v0 = v0 * rs; v1 = v1 * rs; }
                    else { const f32x4 s0 = *(const f32x4*)(SS + col0 + bj * HALF), s1 = *(const f32x4*)(SS + col0 + bj * HALF + 4);
#pragma unroll
                        for (int j = 0; j < 4; ++j) { v0[j] *= __builtin_amdgcn_rsqf(s0[j] * inv_n + EPS); v1[j] *= __builtin_amdgcn_rsqf(s1[j] * inv_n + EPS); } }
                    *(u32x4*)(p + bj * HALF) = pack8(v0, v1); }
                asm volatile("" ::: "memory"); }
    }
};
struct EpiInProj { static constexpr bool PERM = true; bf16_t* O; const float* bgate; float* SSQ; float* SSKV;
    __device__ __forceinline__ void operator()(AccRef acc, const Unit& u, int wr, int wc, int fr, int fq) const {
        const int row0 = u.pm * BM + wr * 64 + fr, col0 = u.pn * BM + wc * 32 + 8 * fq;
        const bool gate = u.pn >= 7;
        f32x4 bv[2][2];
#pragma unroll
        for (int bj = 0; bj < 2; ++bj)
#pragma unroll
            for (int n = 0; n < 2; ++n) bv[bj][n] = gate ? *(const f32x4*)(bgate + (col0 - C_GATE) + bj * HALF + 4 * n) : (f32x4){0.f, 0.f, 0.f, 0.f};
        float* ss0 = (u.pn == 4 || u.pn == 5) ? SSQ : (u.pn == 6 ? SSKV : nullptr);
        float* ss1 = (u.pn == 4) ? SSQ : (u.pn == 5 ? SSKV : nullptr);
#pragma unroll
        for (int ai = 0; ai < 2; ++ai)
#pragma unroll
            for (int m = 0; m < 4; ++m) { const int row = row0 + ai * HALF + m * 16; bf16_t* p = O + (size_t)row * PROJ_LD + col0;
#pragma unroll
                for (int bj = 0; bj < 2; ++bj) { f32x4 v0 = acc[ai][bj][m][0], v1 = acc[ai][bj][m][1];
                    float* ss = bj ? ss1 : ss0;
                    if (ss) { float s = dot8(v0, v1); s += __shfl_xor(s, 16); s += __shfl_xor(s, 32); if (fq == 0) unsafeAtomicAdd(ss + row, s); }
                    if (gate) {
#pragma unroll
                        for (int j = 0; j < 4; ++j) { v0[j] = sigmoidf_(v0[j] + bv[bj][0][j]); v1[j] = sigmoidf_(v1[j] + bv[bj][1][j]); } }
                    *(u32x4*)(p + bj * HALF) = pack8(v0, v1); } }
    }
};
template <int BR> struct EpiMix { static constexpr bool PERM = true; bf16_t* MIX; const bf16_t* PROJ;
    __device__ __forceinline__ void operator()(AccRef acc, const Unit& u, int wr, int wc, int fr, int fq) const {
        const int row0 = u.pm * BM + wr * 64 + fr, col0 = u.pn * BM + wc * 32 + 8 * fq;
#pragma unroll
        for (int ai = 0; ai < 2; ++ai)
#pragma unroll
            for (int m = 0; m < 4; ++m) { const int row = row0 + ai * HALF + m * 16; bf16_t* p = MIX + (size_t)row * D + col0; const bf16_t* gp = PROJ + (size_t)row * PROJ_LD + C_GATE + BR * 1024 + col0;
#pragma unroll
                for (int bj = 0; bj < 2; ++bj) { const u32x4 gw = *(const u32x4*)(gp + bj * HALF);
                    f32x4 g0 = {bf_lo(gw.x), bf_hi(gw.x), bf_lo(gw.y), bf_hi(gw.y)}, g1 = {bf_lo(gw.z), bf_hi(gw.z), bf_lo(gw.w), bf_hi(gw.w)};
                    f32x4 v0 = acc[ai][bj][m][0] * g0, v1 = acc[ai][bj][m][1] * g1;
                    if (BR == 1) { const u32x4 pw = *(const u32x4*)(p + bj * HALF);
                        v0 = v0 + (f32x4){bf_lo(pw.x), bf_hi(pw.x), bf_lo(pw.y), bf_hi(pw.y)}; v1 = v1 + (f32x4){bf_lo(pw.z), bf_hi(pw.z), bf_lo(pw.w), bf_hi(pw.w)}; }
                    *(u32x4*)(p + bj * HALF) = pack8(v0, v1); } }
    }
};
}

constexpr int NWAVES = 8, NTHREADS = 512;
constexpr int LDS_BYTES = 147456;

struct Frame {
    LAS unsigned char* lds;
    int tid, lane, wave, G, bid;
    unsigned char* ws;
    const float* const* in;
    float* out;
};

__device__ __forceinline__ void p0_transpose_item(const float* W, int ldw, bf16_t* dst, int dst_ld, int k0, int n0, const float* gain, LAS float* scr, int lane) {
#pragma unroll 8
    for (int i = 0; i < 32; ++i) { const int kk = 2 * i + (lane >> 5); float v = W[(size_t)(k0 + kk) * ldw + n0 + (lane & 31)]; if (gain) v *= gain[k0 + kk]; scr[kk * 33 + (lane & 31)] = v; }
    asm volatile("s_waitcnt lgkmcnt(0)" ::: "memory");
    const int c = lane & 7;
#pragma unroll
    for (int j = 0; j < 4; ++j) { const int n = (lane >> 3) + 8 * j; const LAS float* s = scr + (8 * c) * 33 + n;
        u32x4 o; o.x = cvt_pk_bf16(s[0 * 33], s[1 * 33]); o.y = cvt_pk_bf16(s[2 * 33], s[3 * 33]); o.z = cvt_pk_bf16(s[4 * 33], s[5 * 33]); o.w = cvt_pk_bf16(s[6 * 33], s[7 * 33]);
        *(u32x4*)(dst + (size_t)n * dst_ld + k0 + 8 * c) = o; }
    asm volatile("s_waitcnt lgkmcnt(0)" ::: "memory");
}
struct TMat { int idx, K, N, mode; size_t dst; int gain_idx; };
__device__ __forceinline__ void p0_transposes(const Frame& F) {
    LAS float* scr = (LAS float*)(F.lds + F.wave * 16384);
    const int gw = F.bid * NWAVES + F.wave, NGW = F.G * NWAVES;
    const TMat tm[12] = {
        {3, 1024, 2816, 1, W_GU1, -1}, {4, 1024, 2816, 2, W_GU1, -1}, {5, 2816, 1024, 0, W_D1, -1},
        {19, 1024, 2816, 1, W_GU2, -1}, {20, 1024, 2816, 2, W_GU2, -1}, {21, 2816, 1024, 0, W_D2, -1},
        {8, 1024, 4256, 3, W_IN, -1}, {11, 384, 768, 0, W_UQ, 10}, {13, 256, 1024, 4, W_UKVK, 12},
        {14, 512, 1024, 0, W_SBO, -1}, {15, 512, 1024, 0, W_MLAO, -1}, {16, 1024, 1024, 0, W_OUT, -1}};
    int base = 0;
#pragma unroll 1
    for (int mi = 0; mi < 12; ++mi) {
        const int K = tm[mi].K, N = tm[mi].N, mode = tm[mi].mode, nblk = N / 32, nitems = (K / 64) * nblk;
        const float* W = F.in[tm[mi].idx]; const float* gain = tm[mi].gain_idx >= 0 ? F.in[tm[mi].gain_idx] : nullptr;
        int it = ((gw - base) % NGW + NGW) % NGW;
        for (; it < nitems; it += NGW) {
            const int kb = it / nblk, nb = it % nblk, k0 = 64 * kb, n0 = 32 * nb;
            bf16_t* dst = (bf16_t*)(F.ws + tm[mi].dst); int drow = n0;
            if (mode == 1) drow = 256 * (n0 >> 7) + (n0 & 127);
            else if (mode == 2) drow = 256 * (n0 >> 7) + 128 + (n0 & 127);
            else if (mode == 3) {
                if (n0 < 1024) drow = n0;
                else if (n0 < 1536) { dst = (bf16_t*)(F.ws + W_SBV); drow = n0 - 1024; }
                else if (n0 < 2208) drow = n0 - 1536 + C_CQ;
                else drow = n0 - 2208 + C_GATE;
            } else if (mode == 4) { const int hd = n0 >> 7, e = n0 & 127;
                if (e < 64) drow = hd * 64 + e; else { dst = (bf16_t*)(F.ws + W_UKVV); drow = hd * 64 + (e - 64); } }
            p0_transpose_item(W, N, dst + (size_t)drow * K, K, k0, n0, gain, scr, F.lane);
        }
        base = (base + nitems) % NGW;
    }
}

template <int MODE>
__device__ __forceinline__ void norm_rows(const Frame& F, const float* SS, float coef, const float* gpost, const float* gpre) {
    const int gw = F.bid * NWAVES + F.wave, NGW = F.G * NWAVES, lane = F.lane;
    const bf16_t* Fb = (const bf16_t*)(F.ws + WS_B); bf16_t* XN = (bf16_t*)(F.ws + WS_A); float* HM = (float*)(F.ws + WS_HM);
    const int rows = (MODE >= 2) ? MX : MT;
    for (int row = gw; row < rows; row += NGW) {
        const float* src; float* hdst = row < MX ? F.out + (size_t)row * D : HM + (size_t)(row - MX) * D;
        if (MODE <= 1) src = row < MX ? F.in[0] + (size_t)row * D : F.in[1] + (size_t)((row - MX) & 15) * D; else src = hdst;
        f32x4 v[4];
#pragma unroll
        for (int j = 0; j < 4; ++j) v[j] = *(const f32x4*)(src + 256 * j + 4 * lane);
        if (MODE >= 1) {
            const float rs = __builtin_amdgcn_rsqf(SS[row] * (1.0f / D) + EPS) * coef;
#pragma unroll
            for (int j = 0; j < 4; ++j) { const u32x2 fw = *(const u32x2*)(Fb + (size_t)row * D + 256 * j + 4 * lane); const f32x4 gp = *(const f32x4*)(gpost + 256 * j + 4 * lane);
                const f32x4 fv = {bf_lo(fw.x), bf_hi(fw.x), bf_lo(fw.y), bf_hi(fw.y)};
                v[j] = v[j] + fv * rs * gp; }
#pragma unroll
            for (int j = 0; j < 4; ++j) *(f32x4*)(hdst + 256 * j + 4 * lane) = v[j];
        }
        if (MODE != 3) {
            float s = 0.f;
#pragma unroll
            for (int j = 0; j < 4; ++j) s += (v[j][0] * v[j][0] + v[j][1] * v[j][1]) + (v[j][2] * v[j][2] + v[j][3] * v[j][3]);
            const float r2 = __builtin_amdgcn_rsqf(wave_sum(s) * (1.0f / D) + EPS);
#pragma unroll
            for (int j = 0; j < 4; ++j) { const f32x4 gp = *(const f32x4*)(gpre + 256 * j + 4 * lane); const f32x4 o = v[j] * r2 * gp;
                u32x2 w; w.x = cvt_pk_bf16(o[0], o[1]); w.y = cvt_pk_bf16(o[2], o[3]); *(u32x2*)(XN + (size_t)row * D + 256 * j + 4 * lane) = w; }
        }
    }
}

constexpr int KROW = 208, VROW = 136;
constexpr int KBUF = 64 * KROW, VBUF = 64 * VROW;
constexpr int ATT_K = 0, ATT_V = 2 * KBUF, ATT_MISC = ATT_V + 2 * VBUF;
#define MFMA32(a, b, c) __builtin_amdgcn_mfma_f32_32x32x16_bf16((a), (b), (c), 0, 0, 0)

struct TileRegs { u32x4 k; u32x4 kr; u32x4 v; };

template <bool MLA>
__device__ __forceinline__ void attn_unit(const Frame& F, int b, int hd, int qb) {
    const int tid = F.tid, lane = F.lane, w = F.wave, r = lane & 31, hh = lane >> 5;
    unsigned char* ws = F.ws;
    const bf16_t* PROJ = (const bf16_t*)(ws + WS_P);
    const bf16_t* KN = (const bf16_t*)(ws + WS_A); const bf16_t* KROPE = KN + (size_t)MT * 512;
    const bf16_t* VT = (const bf16_t*)(ws + WS_B) + (MLA ? (size_t)512 * LDVT : 0);
    const bf16_t* QALL = (const bf16_t*)(ws + WS_C); bf16_t* YM = (bf16_t*)(ws + WS_YM);
    const float* TAB = (const float*)(ws + WS_TAB);
    LAS unsigned char* lds = F.lds;
    const int q0 = qb * 256, qw0 = q0 + 32 * w, tq = qw0 + r;
    const size_t rq = (size_t)b * SEQ + tq;
    constexpr int NKS = MLA ? 6 : 4;
    bf16x8 qf[NKS];
    if (MLA) {
#pragma unroll
        for (int d0 = 0; d0 < 4; ++d0) qf[d0] = *(const bf16x8*)(QALL + rq * 768 + hd * 96 + 16 * d0 + 8 * hh);
        const u32x4 x1w = *(const u32x4*)(QALL + rq * 768 + hd * 96 + 64 + 8 * hh), x2w = *(const u32x4*)(QALL + rq * 768 + hd * 96 + 80 + 8 * hh);
        const float* tp = TAB + ((size_t)(NMETA + tq) * 16 + 8 * hh) * 2;
        u32x4 r1, r2;
#pragma unroll
        for (int jj = 0; jj < 4; ++jj) { const f32x4 cs = *(const f32x4*)(tp + 4 * jj);
            const float a0 = bf_lo(x1w[jj]), a1 = bf_hi(x1w[jj]), b0 = bf_lo(x2w[jj]), b1 = bf_hi(x2w[jj]);
            r1[jj] = cvt_pk_bf16(a0 * cs[0] - b0 * cs[1], a1 * cs[2] - b1 * cs[3]);
            r2[jj] = cvt_pk_bf16(a0 * cs[1] + b0 * cs[0], a1 * cs[3] + b1 * cs[2]); }
        qf[4] = __builtin_bit_cast(bf16x8, r1); qf[5] = __builtin_bit_cast(bf16x8, r2);
    } else {
#pragma unroll
        for (int d0 = 0; d0 < 4; ++d0) qf[d0] = *(const bf16x8*)(PROJ + rq * PROJ_LD + C_SBQ + hd * 64 + 16 * d0 + 8 * hh);
    }
    const int NT = 4 * qb + 5;
    const int kt_d = qw0 >> 6;
    const int lrow = tid >> 3, lch = tid & 7;
    auto load_tile = [&](int it, TileRegs& T) {
        const bool meta = (it == NT - 1); const int kt = 4 * qb + 3 - it;
        const u32x4 z = {0u, 0u, 0u, 0u};
        const size_t krow = meta ? (size_t)MX + lrow : (size_t)b * SEQ + 64 * kt + lrow;
        const bool kvalid = !meta || lrow < 16;
        if (MLA) { T.k = kvalid ? *(const u32x4*)(KN + krow * 512 + hd * 64 + lch * 8) : z;
            if (tid < 256) { const int rr = tid >> 2, cc = tid & 3; const size_t kr2 = meta ? (size_t)MX + rr : (size_t)b * SEQ + 64 * kt + rr;
                T.kr = (!meta || rr < 16) ? *(const u32x4*)(KROPE + kr2 * 32 + cc * 8) : z; }
        } else T.k = kvalid ? *(const u32x4*)(PROJ + krow * PROJ_LD + C_SBK + hd * 64 + lch * 8) : z;
        const size_t vcol = meta ? (size_t)MX + lch * 8 : (size_t)b * SEQ + 64 * kt + lch * 8;
        T.v = (!meta || lch < 2) ? *(const u32x4*)(VT + (size_t)(hd * 64 + lrow) * LDVT + vcol) : z;
    };
    auto store_tile = [&](int buf, const TileRegs& T) {
        *(LAS u32x4*)(lds + ATT_K + buf * KBUF + lrow * KROW + lch * 16) = T.k;
        if (MLA) { if (tid < 256) *(LAS u32x4*)(lds + ATT_K + buf * KBUF + (tid >> 2) * KROW + 128 + (tid & 3) * 16) = T.kr; }
        LAS unsigned char* vp = lds + ATT_V + buf * VBUF + lrow * VROW + lch * 16;
        *(LAS u32x2*)vp = (u32x2){T.v.x, T.v.y}; *(LAS u32x2*)(vp + 8) = (u32x2){T.v.z, T.v.w};
    };
    f32x16 o0, o1;
#pragma unroll
    for (int i = 0; i < 16; ++i) { o0[i] = 0.f; o1[i] = 0.f; }
    float R = 1.0f;
    float mrun = -1e30f, lrun = 0.f;
    TileRegs T; T.kr = (u32x4){0u, 0u, 0u, 0u};
    load_tile(0, T); store_tile(0, T);
    __syncthreads();
    for (int it = 0; it < NT; ++it) {
        const int cur = it & 1; const bool meta = (it == NT - 1); const int kt = 4 * qb + 3 - it;
        if (it + 1 < NT) load_tile(it + 1, T);
        const bool active = meta || kt <= kt_d;
        if (active) {
            f32x16 p0, p1;
#pragma unroll
            for (int i = 0; i < 16; ++i) { p0[i] = 0.f; p1[i] = 0.f; }
            const LAS unsigned char* kb = lds + ATT_K + cur * KBUF + r * KROW + hh * 16;
#pragma unroll
            for (int d0 = 0; d0 < NKS; ++d0) { const bf16x8 k0 = *(const LAS bf16x8*)(kb + d0 * 32), k1 = *(const LAS bf16x8*)(kb + 32 * KROW + d0 * 32);
                p0 = MFMA32(k0, qf[d0], p0); p1 = MFMA32(k1, qf[d0], p1); }
            if (MLA) {
                if (meta) {
#pragma unroll
                    for (int i = 0; i < 16; ++i) { const int kk = 8 * (i >> 2) + 4 * hh + (i & 3); if (kk >= 16) p0[i] = -1e30f; p1[i] = -1e30f; }
                }
                float mx = p0[0];
#pragma unroll
                for (int i = 1; i < 16; ++i) mx = fmaxf(mx, p0[i]);
#pragma unroll
                for (int i = 0; i < 16; ++i) mx = fmaxf(mx, p1[i]);
                mx = fmaxf(mx, __shfl_xor(mx, 32));
                const float mnew = fmaxf(mrun, mx), fsc = fexp2(mrun - mnew); mrun = mnew; lrun *= fsc;
#pragma unroll
                for (int i = 0; i < 16; ++i) { o0[i] *= fsc; o1[i] *= fsc; }
                float ls = 0.f;
#pragma unroll
                for (int i = 0; i < 16; ++i) { p0[i] = fexp2(p0[i] - mnew); p1[i] = fexp2(p1[i] - mnew); ls += p0[i] + p1[i]; }
                lrun += ls;
            } else {
                const int lim = meta ? 16 : (kt == kt_d ? tq - 64 * kt : 64);
                f32x16 m0, m1;
#pragma unroll
                for (int i = 0; i < 16; ++i) { const int kk = 8 * (i >> 2) + 4 * hh + (i & 3);
                    { const float s = p0[i], e = fexp2(-fabsf(s) * SB_C), d = frcp(1.0f + e), sm = e * d; const bool ps = s > 0.f, vl = kk < lim;
                      p0[i] = vl ? (ps ? d : sm) : 0.f; m0[i] = vl ? (ps ? sm : d) : 1.f; }
                    { const float s = p1[i], e = fexp2(-fabsf(s) * SB_C), d = frcp(1.0f + e), sm = e * d; const bool ps = s > 0.f, vl = (kk + 32) < lim;
                      p1[i] = vl ? (ps ? d : sm) : 0.f; m1[i] = vl ? (ps ? sm : d) : 1.f; } }
                float Pr = R;
#define SB_GROUP(PV, MV, G4) do { const float oa = MV[G4], ob = MV[G4 + 1], oc = MV[G4 + 2], od = MV[G4 + 3]; const float Tm = (oa * ob) * (oc * od), To = __shfl_xor(Tm, 32); \
                    float pre = hh ? Pr : Pr * To; Pr = Pr * (Tm * To); PV[G4 + 3] *= pre; pre *= od; PV[G4 + 2] *= pre; pre *= oc; PV[G4 + 1] *= pre; pre *= ob; PV[G4] *= pre; } while (0)
                SB_GROUP(p1, m1, 12); SB_GROUP(p1, m1, 8); SB_GROUP(p1, m1, 4); SB_GROUP(p1, m1, 0);
                SB_GROUP(p0, m0, 12); SB_GROUP(p0, m0, 8); SB_GROUP(p0, m0, 4); SB_GROUP(p0, m0, 0);
#undef SB_GROUP
                R = Pr;
            }
            bf16x8 pa[4];
            { u32x4 t;
              t.x = cvt_pk_bf16(p0[0], p0[1]); t.y = cvt_pk_bf16(p0[2], p0[3]); t.z = cvt_pk_bf16(p0[4], p0[5]); t.w = cvt_pk_bf16(p0[6], p0[7]); pa[0] = __builtin_bit_cast(bf16x8, t);
              t.x = cvt_pk_bf16(p0[8], p0[9]); t.y = cvt_pk_bf16(p0[10], p0[11]); t.z = cvt_pk_bf16(p0[12], p0[13]); t.w = cvt_pk_bf16(p0[14], p0[15]); pa[1] = __builtin_bit_cast(bf16x8, t);
              t.x = cvt_pk_bf16(p1[0], p1[1]); t.y = cvt_pk_bf16(p1[2], p1[3]); t.z = cvt_pk_bf16(p1[4], p1[5]); t.w = cvt_pk_bf16(p1[6], p1[7]); pa[2] = __builtin_bit_cast(bf16x8, t);
              t.x = cvt_pk_bf16(p1[8], p1[9]); t.y = cvt_pk_bf16(p1[10], p1[11]); t.z = cvt_pk_bf16(p1[12], p1[13]); t.w = cvt_pk_bf16(p1[14], p1[15]); pa[3] = __builtin_bit_cast(bf16x8, t); }
            const LAS unsigned char* vb = lds + ATT_V + cur * VBUF + r * VROW + hh * 8;
#pragma unroll
            for (int s = 0; s < 4; ++s) {
                const s16x4 a0 = *(const LAS s16x4*)(vb + s * 32), a1 = *(const LAS s16x4*)(vb + s * 32 + 16);
                const s16x4 c0 = *(const LAS s16x4*)(vb + 32 * VROW + s * 32), c1 = *(const LAS s16x4*)(vb + 32 * VROW + s * 32 + 16);
                const bf16x8 vf0 = __builtin_shufflevector(a0, a1, 0, 1, 2, 3, 4, 5, 6, 7), vf1 = __builtin_shufflevector(c0, c1, 0, 1, 2, 3, 4, 5, 6, 7);
                o0 = MFMA32(vf0, pa[s], o0); o1 = MFMA32(vf1, pa[s], o1);
            }
        }
        if (it + 1 < NT) store_tile(cur ^ 1, T);
        if (MLA) __syncthreads();
        else {
            const int wdone = (active && __all(R < 1e-30f)) ? 1 : 0;
            if (__syncthreads_and(wdone)) break;
        }
    }
    float inv = 1.0f;
    if (MLA) { const float lt = lrun + __shfl_xor(lrun, 32); inv = 1.0f / lt; }
    bf16_t* yrow = MLA ? YM + rq * 512 + hd * 64 : (bf16_t*)(ws + WS_P) + rq * PROJ_LD + C_SBQ + hd * 64;
#pragma unroll
    for (int g = 0; g < 4; ++g) {
        u32x2 w0, w1;
        w0.x = cvt_pk_bf16(o0[4 * g] * inv, o0[4 * g + 1] * inv); w0.y = cvt_pk_bf16(o0[4 * g + 2] * inv, o0[4 * g + 3] * inv);
        w1.x = cvt_pk_bf16(o1[4 * g] * inv, o1[4 * g + 1] * inv); w1.y = cvt_pk_bf16(o1[4 * g + 2] * inv, o1[4 * g + 3] * inv);
        *(u32x2*)(yrow + 8 * g + 4 * hh) = w0; *(u32x2*)(yrow + 32 + 8 * g + 4 * hh) = w1;
    }
    __syncthreads();
}

__device__ __forceinline__ void attn_phase(const Frame& F) {
    unsigned* ctr = (unsigned*)(F.ws + WS_CTL);
    LAS unsigned* slot = (LAS unsigned*)(F.lds + ATT_MISC);
    for (;;) {
        if (F.tid == 0) *slot = atomicAdd(ctr, 1u);
        __syncthreads();
        const unsigned u = *slot;
        __syncthreads();
        if (u >= 2048u) break;
        const int uu = (int)(u & 1023u), qb = 7 - (uu >> 7), bh = uu & 127;
        if (u < 1024u) attn_unit<true>(F, bh >> 3, bh & 7, qb); else attn_unit<false>(F, bh >> 3, bh & 7, qb);
    }
}

__global__ void __launch_bounds__(NTHREADS, 2) fwd_kernel(Params P) {
    extern __shared__ __attribute__((aligned(16))) unsigned char lds_raw[];
#define MKFRAME() Frame F; { int t_ = threadIdx.x; asm volatile("" : "+v"(t_)); F.lds = (LAS unsigned char*)lds_raw; F.tid = t_; F.lane = t_ & 63; F.wave = __builtin_amdgcn_readfirstlane(t_ >> 6); \
        F.G = gridDim.x; F.bid = blockIdx.x; F.ws = P.ws; F.in = P.in; F.out = P.out; } const int gtid = F.bid * NTHREADS + F.tid, GT = F.G * NTHREADS; (void)gtid; (void)GT
    unsigned char* ws = P.ws;
    const int lo = P.ph_lo, hi = P.ph_hi;
#ifndef PHMASK
#define PHMASK 0x1fff
#endif
#define IN(k) (((PHMASK >> (k)) & 1) && lo <= (k) && (k) < hi)
#define SEAM(k) do { if (IN(k) && IN((k) + 1)) { asm volatile("s_waitcnt vmcnt(0) lgkmcnt(0)" ::: "memory"); cg::this_grid().sync(); \
        __builtin_amdgcn_fence(__ATOMIC_ACQUIRE, "agent"); asm volatile("s_waitcnt vmcnt(0)" ::: "memory"); } } while (0)
    float* SS1 = (float*)(ws + WS_SS); float* SS2 = SS1 + MT; float* SS3 = SS2 + MT; float* SSQ = SS3 + MT; float* SSKV = SSQ + MT;
    float* TAB = (float*)(ws + WS_TAB);
    bf16_t* XN = (bf16_t*)(ws + WS_A); bf16_t* FB = (bf16_t*)(ws + WS_B); bf16_t* PROJ = (bf16_t*)(ws + WS_P); bf16_t* HID = PROJ;
    bf16_t* KN = XN; bf16_t* KROPE = KN + (size_t)MT * 512; bf16_t* MIX = XN;
    bf16_t* VTSB = FB; bf16_t* VTMLA = FB + (size_t)512 * LDVT;
    bf16_t* QALL = (bf16_t*)(ws + WS_C); bf16_t* YM = (bf16_t*)(ws + WS_YM);

    if (IN(0)) { MKFRAME();
        p0_transposes(F);
        for (int i = gtid; i < 5 * MT; i += GT) SS1[i] = 0.f;
        if (gtid == 0) *(unsigned*)(ws + WS_CTL) = 0u;
        for (int i = gtid; i < 2064 * 16; i += GT) { const int pos = i >> 4, j = i & 15; const float ang = (float)pos * P.inv_freq[j];
            const double rev = (double)ang * 0.15915494309189535; const float fr = (float)(rev - __builtin_rint(rev));
            TAB[2 * i] = __builtin_amdgcn_cosf(fr); TAB[2 * i + 1] = __builtin_amdgcn_sinf(fr); }
        norm_rows<0>(F, nullptr, 0.f, nullptr, P.in[2]);
    }
    SEAM(0);
    if (IN(1)) { MKFRAME(); pg8::Gemm g{XN, (const bf16_t*)(ws + W_GU1), MT, 5632, 1024, 1024, 1024}; pg8::StaticOrder S; S.init(MT, 5632, F.G, F.bid);
        pg8::EpiSwiglu E{HID}; pg8::gemm_phase(F.lds, g, S, E); }
    SEAM(1);
    if (IN(2)) { MKFRAME(); pg8::Gemm g{HID, (const bf16_t*)(ws + W_D1), MT, 1024, 2816, 2816, 2816}; pg8::StaticOrder S; S.init(MT, 1024, F.G, F.bid);
        pg8::EpiStoreSS E{FB, D, SS1}; pg8::gemm_phase(F.lds, g, S, E); }
    SEAM(2);
    if (IN(3)) { MKFRAME(); norm_rows<1>(F, SS1, 0.5f, P.in[6], P.in[7]); }
    SEAM(3);
    if (IN(4)) { MKFRAME();
        { pg8::Gemm g{XN, (const bf16_t*)(ws + W_IN), MT, PROJ_LD, 1024, 1024, 1024}; pg8::StaticOrder S; S.init(MT, PROJ_LD, F.G, F.bid);
          pg8::EpiInProj E{PROJ, P.in[9], SSQ, SSKV}; pg8::gemm_phase(F.lds, g, S, E); }
        { pg8::Gemm g{(const bf16_t*)(ws + W_SBV), XN, 512, MT, 1024, 1024, 1024}; pg8::StaticOrder S; S.init(512, MT, F.G, (F.bid + 128) & 255);
          pg8::EpiStoreSS E{VTSB, LDVT, nullptr}; pg8::gemm_phase(F.lds, g, S, E); }
    }
    SEAM(4);
    if (IN(5)) { MKFRAME();
        for (int i = gtid; i < MT * 16; i += GT) { const int row = i >> 4, j = i & 15; const int pos = row_pos(row);
            const float c = TAB[(pos * 16 + j) * 2], s = TAB[(pos * 16 + j) * 2 + 1];
            const float x1 = __uint_as_float((unsigned)PROJ[(size_t)row * PROJ_LD + C_KR + j] << 16), x2 = __uint_as_float((unsigned)PROJ[(size_t)row * PROJ_LD + C_KR + 16 + j] << 16);
            const unsigned a = cvt_pk_bf16(x1 * c - x2 * s, x1 * s + x2 * c);
            KROPE[(size_t)row * 32 + j] = (bf16_t)(a & 0xffffu); KROPE[(size_t)row * 32 + 16 + j] = (bf16_t)(a >> 16); }
#ifndef P5SUB
#define P5SUB 7
#endif
        if (P5SUB & 1) { pg8::Gemm g{PROJ + C_CQ, (const bf16_t*)(ws + W_UQ), MX, 768, 384, PROJ_LD, 384}; pg8::StaticOrder S; S.init(MX, 768, F.G, F.bid);
          pg8::EpiScaled<1> E{QALL, 768, SSQ, 1.0f / 384.0f, MLA_QSCALE}; pg8::gemm_phase(F.lds, g, S, E); }
        if (P5SUB & 2) { pg8::Gemm g{PROJ + C_CKV, (const bf16_t*)(ws + W_UKVK), MT, 512, 256, PROJ_LD, 256}; pg8::StaticOrder S; S.init(MT, 512, F.G, (F.bid + 120) & 255);
          pg8::EpiScaled<1> E{KN, 512, SSKV, 1.0f / 256.0f, 1.0f}; pg8::gemm_phase(F.lds, g, S, E); }
        if (P5SUB & 4) { pg8::Gemm g{(const bf16_t*)(ws + W_UKVV), PROJ + C_CKV, 512, MT, 256, 256, PROJ_LD}; pg8::StaticOrder S; S.init(512, MT, F.G, (F.bid + 112) & 255);
          pg8::EpiScaled<2> E{VTMLA, LDVT, SSKV, 1.0f / 256.0f, 1.0f}; pg8::gemm_phase(F.lds, g, S, E); }
    }
    SEAM(5);
    if (IN(6)) { MKFRAME(); attn_phase(F); }
    SEAM(6);
    if (IN(7)) { MKFRAME();
        { pg8::Gemm g{PROJ + C_SBQ, (const bf16_t*)(ws + W_SBO), MX, 1024, 512, PROJ_LD, 512}; pg8::StaticOrder S; S.init(MX, 1024, F.G, F.bid);
          pg8::EpiMix<0> E{MIX, PROJ}; pg8::gemm_phase(F.lds, g, S, E); }
        { pg8::Gemm g{YM, (const bf16_t*)(ws + W_MLAO), MX, 1024, 512, 512, 512}; pg8::StaticOrder S; S.init(MX, 1024, F.G, F.bid);
          pg8::EpiMix<1> E{MIX, PROJ}; pg8::gemm_phase(F.lds, g, S, E); }
    }
    SEAM(7);
    if (IN(8)) { MKFRAME(); pg8::Gemm g{MIX, (const bf16_t*)(ws + W_OUT), MX, 1024, 1024, 1024, 1024}; pg8::StaticOrder S; S.init(MX, 1024, F.G, F.bid);
        pg8::EpiStoreSS E{FB, D, SS2}; pg8::gemm_phase(F.lds, g, S, E); }
    SEAM(8);
    if (IN(9)) { MKFRAME(); norm_rows<2>(F, SS2, 1.0f, P.in[17], P.in[18]); }
    SEAM(9);
    if (IN(10)) { MKFRAME(); pg8::Gemm g{XN, (const bf16_t*)(ws + W_GU2), MX, 5632, 1024, 1024, 1024}; pg8::StaticOrder S; S.init(MX, 5632, F.G, F.bid);
        pg8::EpiSwiglu E{HID}; pg8::gemm_phase(F.lds, g, S, E); }
    SEAM(10);
    if (IN(11)) { MKFRAME(); pg8::Gemm g{HID, (const bf16_t*)(ws + W_D2), MX, 1024, 2816, 2816, 2816}; pg8::StaticOrder S; S.init(MX, 1024, F.G, F.bid);
        pg8::EpiStoreSS E{FB, D, SS3}; pg8::gemm_phase(F.lds, g, S, E); }
    SEAM(11);
    if (IN(12)) { MKFRAME(); norm_rows<3>(F, SS3, 0.5f, P.in[22], nullptr); }
#undef IN
#undef SEAM
}

extern "C" void kernel_launch(void* const* d_in, const int* in_sizes, int n_in, void* d_out, int out_size, void* d_ws, size_t ws_size, hipStream_t stream) {
    static int grid = 0;
    if (grid == 0) {
        if (n_in != 23 || out_size != MX * D || ws_size < WS_END) { fprintf(stderr, "kernel_launch: unexpected shapes (n_in %d out %d ws %zu)\n", n_in, out_size, ws_size); grid = -1; return; }
        if (hipFuncSetAttribute((const void*)fwd_kernel, hipFuncAttributeMaxDynamicSharedMemorySize, LDS_BYTES) != hipSuccess) { fprintf(stderr, "kernel_launch: hipFuncSetAttribute failed\n"); grid = -1; return; }
        int dev = 0, cus = 0, per_cu = 0;
        (void)hipGetDevice(&dev); (void)hipDeviceGetAttribute(&cus, hipDeviceAttributeMultiprocessorCount, dev);
        (void)hipOccupancyMaxActiveBlocksPerMultiprocessor(&per_cu, (const void*)fwd_kernel, NTHREADS, LDS_BYTES);
        if (per_cu < 1) fprintf(stderr, "kernel_launch: occupancy query says %d blocks/CU\n", per_cu);
        (void)hipGetLastError();
        grid = cus > 0 ? cus : 256;
    }
    if (grid < 0) return;
    Params p{};
    for (int i = 0; i < 23; ++i) p.in[i] = (const float*)d_in[i];
    p.out = (float*)d_out; p.ws = (unsigned char*)d_ws;
    for (int j = 0; j < 16; ++j) p.inv_freq[j] = powf(10000.0f, -(float)j / 16.0f);
#if ONE_LAUNCH
    p.ph_lo = 0; p.ph_hi = 13;
    void* args[] = {&p};
    hipError_t e = hipLaunchCooperativeKernel((const void*)fwd_kernel, dim3(grid), dim3(NTHREADS), args, LDS_BYTES, stream);
    if (e != hipSuccess) fprintf(stderr, "kernel_launch: cooperative launch failed: %s (grid %d)\n", hipGetErrorString(e), grid);
#else
    for (int ph = 0; ph < 13; ++ph) { p.ph_lo = ph; p.ph_hi = ph + 1; hipLaunchKernelGGL(fwd_kernel, dim3(grid), dim3(NTHREADS), LDS_BYTES, stream, p); }
#endif
}
```

```cpp
#include <hip/hip_runtime.h>
#include <hip/hip_cooperative_groups.h>
#include <cstdio>
#include <cstdint>
namespace cg = cooperative_groups;

#ifndef ONE_LAUNCH
#define ONE_LAUNCH 1
#endif

#define LAS __attribute__((address_space(3)))
typedef unsigned short bf16_t;
typedef short bf16x8 __attribute__((ext_vector_type(8)));
typedef short s16x4 __attribute__((ext_vector_type(4)));
typedef float f32x4 __attribute__((ext_vector_type(4)));
typedef float f32x16 __attribute__((ext_vector_type(16)));
typedef unsigned u32x4 __attribute__((ext_vector_type(4)));
typedef unsigned u32x2 __attribute__((ext_vector_type(2)));

constexpr int D = 1024, FF = 2816, NB = 16, SEQ = 2048, NMETA = 16;
constexpr int MX = NB * SEQ;
constexpr int MT = MX + 256;
constexpr int PROJ_LD = 3840;
constexpr int C_SBQ = 0, C_SBK = 512, C_CQ = 1024, C_CKV = 1408, C_KR = 1664, C_GATE = 1792;
constexpr int LDVT = MT;
constexpr float EPS = 1e-6f;
constexpr float LOG2E = 1.4426950408889634f;
constexpr float SB_C = 0.125f * LOG2E;
constexpr float MLA_QSCALE = 0.10206207261596577f * LOG2E;

constexpr size_t MiB = 1u << 20;
constexpr size_t WS_CTL = 0;
constexpr size_t WS_SS = 1 * MiB;
constexpr size_t WS_TAB = 2 * MiB;
constexpr size_t WS_HM = 3 * MiB;
constexpr size_t WS_W = 4 * MiB;
constexpr size_t W_GU1 = WS_W, W_D1 = W_GU1 + (size_t)5632 * 1024 * 2, W_GU2 = W_D1 + (size_t)1024 * 2816 * 2, W_D2 = W_GU2 + (size_t)5632 * 1024 * 2;
constexpr size_t W_IN = W_D2 + (size_t)1024 * 2816 * 2, W_SBV = W_IN + (size_t)3840 * 1024 * 2, W_UQ = W_SBV + (size_t)512 * 1024 * 2;
constexpr size_t W_UKVK = W_UQ + (size_t)768 * 384 * 2, W_UKVV = W_UKVK + (size_t)512 * 256 * 2, W_SBO = W_UKVV + (size_t)512 * 256 * 2;
constexpr size_t W_MLAO = W_SBO + (size_t)1024 * 512 * 2, W_OUT = W_MLAO + (size_t)1024 * 512 * 2, W_END = W_OUT + (size_t)1024 * 1024 * 2;
static_assert(W_END <= 52 * MiB, "weights");
constexpr size_t WS_A = 52 * MiB;
constexpr size_t RSZ = (size_t)MT * 1024 * 2;
constexpr size_t WS_B = WS_A + RSZ;
constexpr size_t WS_C = WS_B + RSZ;
constexpr size_t WS_YM = WS_C + (size_t)MT * 768 * 2;
constexpr size_t WS_P = WS_YM + (size_t)MT * 512 * 2;
constexpr size_t WS_END = WS_P + (size_t)MT * PROJ_LD * 2;
static_assert(WS_END <= 512 * MiB, "workspace");

struct Params {
    const float* in[23];
    float* out;
    unsigned char* ws;
    float inv_freq[16];
    int ph_lo, ph_hi;
};

__device__ __forceinline__ unsigned cvt_pk_bf16(float lo, float hi) { unsigned r; asm volatile("v_cvt_pk_bf16_f32 %0, %1, %2" : "=v"(r) : "v"(lo), "v"(hi)); return r; }
__device__ __forceinline__ float bf_lo(unsigned u) { return __uint_as_float(u << 16); }
__device__ __forceinline__ float bf_hi(unsigned u) { return __uint_as_float(u & 0xffff0000u); }
__device__ __forceinline__ float fexp2(float x) { return __builtin_amdgcn_exp2f(x); }
__device__ __forceinline__ float frcp(float x) { return __builtin_amdgcn_rcpf(x); }
__device__ __forceinline__ float sigmoidf_(float x) { return frcp(1.0f + fexp2(-x * LOG2E)); }
__device__ __forceinline__ float wave_sum(float v) {
#pragma unroll
    for (int o = 1; o < 64; o <<= 1) v += __shfl_xor(v, o);
    return v;
}
__device__ __forceinline__ int row_pos(int row) { return row < MX ? NMETA + (row & (SEQ - 1)) : ((row - MX) & 15); }

namespace pg8 {
constexpr int BM = 256, BK = 64, HALF = 128, HTB = HALF * BK * 2, STAGE_BYTES = 8 * HTB, NXCD = 8, WGM = 8;
__device__ __forceinline__ int lds_byte(int r, int c) { const int st = (r >> 4) * 2 + (c >> 5), rr = r & 15, cc = c & 31, ob = rr * 64 + cc * 2; return st * 1024 + (ob ^ (((ob >> 9) & 1) << 5)); }
__device__ __forceinline__ void stage_rc(int b, int& R, int& C) { const int st = b / 1024, sb = b % 1024, swz = sb ^ (((sb >> 9) & 1) << 5); R = (st >> 1) * 16 + swz / 64; C = (st & 1) * 32 + (swz % 64) / 2; }
__device__ __forceinline__ int perm32(int rho) { const int n = rho >> 4, i = rho & 15; return 8 * (i >> 2) + 4 * n + (i & 3); }

struct Unit { int pm, pn; };
struct Gemm { const bf16_t* A; const bf16_t* Bt; int M, N, K, lda, ldb; };

struct StaticOrder {
    int nM, nN, nwg, G, c;
    __device__ void init(int M, int N, int G_, int c_) { nM = M / BM; nN = N / BM; nwg = nM * nN; G = G_; c = c_; }
    __device__ bool next(int i, Unit& u) const {
        const long L = (long)i * G + c; if (L >= nwg) return false;
        int wgid = (int)L; { const int q = nwg / NXCD, r = nwg % NXCD, xcd = wgid % NXCD, off = wgid / NXCD; wgid = (xcd < r ? xcd * (q + 1) : r * (q + 1) + (xcd - r) * q) + off; }
        const int nig = WGM * nN, gid = wgid / nig, fm = gid * WGM, gsz = (nM - fm) < WGM ? (nM - fm) : WGM;
        u.pm = fm + ((wgid % nig) % gsz); u.pn = (wgid % nig) / gsz; return true;
    }
};

template <class Epi>
__device__ __forceinline__ void gemm_phase(LAS unsigned char* lds, const Gemm g, const StaticOrder& S, const Epi& E) {
    const int tid = threadIdx.x, wid = __builtin_amdgcn_readfirstlane(tid >> 6), lane = tid & 63, wr = wid >> 2, wc = wid & 3, fr = lane & 15, fq = lane >> 4;
    const int K = g.K, nt = K / BK;
    unsigned voffA[2], voffB[2];
#pragma unroll
    for (int i = 0; i < 2; ++i) { int R, C; stage_rc(tid * 16 + i * 8192, R, C); const int Rb = Epi::PERM ? ((R & ~31) + perm32(R & 31)) : R;
        voffA[i] = (unsigned)(R * g.lda + C) * 2u; voffB[i] = (unsigned)(Rb * g.ldb + C) * 2u; }
    const size_t kstep = (size_t)(BK * 2);
    const size_t hA = (size_t)HALF * g.lda * 2, hB = (size_t)HALF * g.ldb * 2, tA = 2 * hA, tB = 2 * hB;
    const unsigned ldsw = (unsigned)wid * 1024u;
    const int aoff = lds_byte(wr * 64 + fr, fq * 8), boff = lds_byte(wc * 32 + fr, fq * 8);
#define PG8_SA(b, h) (((b) * 2 + (h)) * HTB)
#define PG8_SB(b, h) ((4 + (b) * 2 + (h)) * HTB)
#define PG8_STAGE(bufoff, gbase, voff) do { _Pragma("unroll") for (int _i = 0; _i < 2; ++_i) \
        __builtin_amdgcn_global_load_lds((const unsigned*)((const char*)(gbase) + (voff)[_i]), (LAS unsigned*)(lds + (bufoff) + ldsw + _i * 8192), 16, 0, 0); } while (0)
#define PG8_LDA(dst, b, h) do { _Pragma("unroll") for (int m = 0; m < 4; ++m) _Pragma("unroll") for (int k = 0; k < 2; ++k) dst[m][k] = *(const LAS bf16x8*)(lds + PG8_SA(b, h) + aoff + m * 2048 + k * 1024); } while (0)
#define PG8_LDB(dst, b, h) do { _Pragma("unroll") for (int n = 0; n < 2; ++n) _Pragma("unroll") for (int k = 0; k < 2; ++k) dst[n][k] = *(const LAS bf16x8*)(lds + PG8_SB(b, h) + boff + n * 2048 + k * 1024); } while (0)
#define PG8_MMA(ai, bj, At, Bt) do { __builtin_amdgcn_s_setprio(1); _Pragma("unroll") for (int m = 0; m < 4; ++m) _Pragma("unroll") for (int n = 0; n < 2; ++n) _Pragma("unroll") for (int k = 0; k < 2; ++k) \
        acc[ai][bj][m][n] = __builtin_amdgcn_mfma_f32_16x16x32_bf16(Bt[n][k], At[m][k], acc[ai][bj][m][n], 0, 0, 0); __builtin_amdgcn_s_setprio(0); } while (0)
#define PG8_WAIT_V(n) asm volatile("s_waitcnt vmcnt(" #n ")" ::: "memory")
#define PG8_WAIT_L(n) asm volatile("s_waitcnt lgkmcnt(" #n ")" ::: "memory")
#define PG8_BAR __builtin_amdgcn_s_barrier()
#define PG8_SCHED __builtin_amdgcn_sched_barrier(0)
    Unit cur, nxt; int ui = 0;
    if (!S.next(0, cur)) return;
    f32x4 acc[2][2][4][2];
#pragma unroll
    for (int a = 0; a < 2; ++a)
#pragma unroll
        for (int b = 0; b < 2; ++b)
#pragma unroll
            for (int m = 0; m < 4; ++m)
#pragma unroll
                for (int n = 0; n < 2; ++n) acc[a][b][m][n] = (f32x4){0.f, 0.f, 0.f, 0.f};
    bf16x8 At[4][2], B0[2][2], B1[2][2];
    const char* cA = (const char*)g.A + (size_t)cur.pm * tA; const char* cB = (const char*)g.Bt + (size_t)cur.pn * tB;
    PG8_STAGE(PG8_SB(0, 0), cB, voffB); PG8_STAGE(PG8_SB(0, 1), cB + hB, voffB); PG8_STAGE(PG8_SA(0, 0), cA, voffA); PG8_STAGE(PG8_SA(0, 1), cA + hA, voffA);
    if (wr == 1) PG8_BAR;
    PG8_WAIT_V(2); PG8_BAR;
    PG8_STAGE(PG8_SB(1, 0), cB + kstep, voffB); PG8_STAGE(PG8_SA(1, 0), cA + kstep, voffA); PG8_STAGE(PG8_SB(1, 1), cB + hB + kstep, voffB);
    PG8_WAIT_V(6); PG8_BAR;
    for (;;) {
        const bool has_next = S.next(ui + 1, nxt);
        const char* nA = has_next ? (const char*)g.A + (size_t)nxt.pm * tA : cA; const char* nB = has_next ? (const char*)g.Bt + (size_t)nxt.pn * tB : cB;
        for (int t = 0; t < nt; t += 2) {
            const bool last = (t == nt - 2);
            const char* a1 = cA + (size_t)(t + 1) * kstep;
            const char* a2 = last ? nA : cA + (size_t)(t + 2) * kstep; const char* b2 = last ? nB : cB + (size_t)(t + 2) * kstep;
            const char* a3 = a2 + kstep; const char* b3 = b2 + kstep;
            PG8_LDB(B0, 0, 0); PG8_LDB(B1, 0, 1); PG8_SCHED; PG8_LDA(At, 0, 0); PG8_STAGE(PG8_SA(1, 1), a1 + hA, voffA);
            PG8_WAIT_V(8); PG8_WAIT_L(0); PG8_BAR; PG8_MMA(0, 0, At, B0); PG8_MMA(0, 1, At, B1); PG8_BAR; PG8_SCHED;
            PG8_LDA(At, 0, 1); PG8_STAGE(PG8_SB(0, 0), b2, voffB); PG8_STAGE(PG8_SB(0, 1), b2 + hB, voffB); PG8_STAGE(PG8_SA(0, 0), a2, voffA);
            PG8_WAIT_V(8); PG8_WAIT_L(0); PG8_BAR; PG8_MMA(1, 0, At, B0); PG8_MMA(1, 1, At, B1); PG8_BAR; PG8_SCHED;
            PG8_LDB(B0, 1, 0); PG8_LDB(B1, 1, 1); PG8_SCHED; PG8_LDA(At, 1, 0); PG8_STAGE(PG8_SA(0, 1), a2 + hA, voffA);
            PG8_WAIT_V(8); PG8_WAIT_L(0); PG8_BAR; PG8_MMA(0, 0, At, B0); PG8_MMA(0, 1, At, B1); PG8_BAR; PG8_SCHED;
            PG8_LDA(At, 1, 1); PG8_STAGE(PG8_SB(1, 0), b3, voffB); PG8_STAGE(PG8_SB(1, 1), b3 + hB, voffB); PG8_STAGE(PG8_SA(1, 0), a3, voffA);
            PG8_WAIT_V(8); PG8_WAIT_L(0); PG8_BAR; PG8_MMA(1, 0, At, B0); PG8_MMA(1, 1, At, B1); PG8_BAR; PG8_SCHED;
        }
        if (wr == 0) PG8_BAR;
        E(acc, cur, wr, wc, fr, fq);
        if (!has_next) break;
#pragma unroll
        for (int a = 0; a < 2; ++a)
#pragma unroll
            for (int b = 0; b < 2; ++b)
#pragma unroll
                for (int m = 0; m < 4; ++m)
#pragma unroll
                    for (int n = 0; n < 2; ++n) acc[a][b][m][n] = (f32x4){0.f, 0.f, 0.f, 0.f};
        cur = nxt; cA = nA; cB = nB; ++ui;
        if (wr == 1) PG8_BAR;
    }
    PG8_WAIT_V(0);
    PG8_BAR;
#undef PG8_SA
#undef PG8_SB
#undef PG8_STAGE
#undef PG8_LDA
#undef PG8_LDB
#undef PG8_MMA
#undef PG8_WAIT_V
#undef PG8_WAIT_L
#undef PG8_BAR
#undef PG8_SCHED
}

typedef const f32x4 (&AccRef)[2][2][4][2];
__device__ __forceinline__ u32x4 pack8(const f32x4 v0, const f32x4 v1) { u32x4 w; w.x = cvt_pk_bf16(v0[0], v0[1]); w.y = cvt_pk_bf16(v0[2], v0[3]); w.z = cvt_pk_bf16(v1[0], v1[1]); w.w = cvt_pk_bf16(v1[2], v1[3]); return w; }
__device__ __forceinline__ float dot8(const f32x4 a, const f32x4 b) { return (a[0] * a[0] + a[1] * a[1]) + (a[2] * a[2] + a[3] * a[3]) + (b[0] * b[0] + b[1] * b[1]) + (b[2] * b[2] + b[3] * b[3]); }

struct EpiSwiglu { static constexpr bool PERM = true; bf16_t* O;
    __device__ __forceinline__ void operator()(AccRef acc, const Unit& u, int wr, int wc, int fr, int fq) const {
        const int row0 = u.pm * BM + wr * 64 + fr, col0 = u.pn * 128 + wc * 32 + 8 * fq;
#pragma unroll
        for (int ai = 0; ai < 2; ++ai)
#pragma unroll
            for (int m = 0; m < 4; ++m) { bf16_t* p = O + (size_t)(row0 + ai * HALF + m * 16) * FF + col0;
                f32x4 h0, h1;
#pragma unroll
                for (int j = 0; j < 4; ++j) { const float g0 = acc[ai][0][m][0][j], g1 = acc[ai][0][m][1][j];
                    h0[j] = g0 * sigmoidf_(g0) * acc[ai][1][m][0][j]; h1[j] = g1 * sigmoidf_(g1) * acc[ai][1][m][1][j]; }
                *(u32x4*)p = pack8(h0, h1); }
    }
};
struct EpiStoreSS { static constexpr bool PERM = true; bf16_t* O; int ldc; float* SS;
    __device__ __forceinline__ void operator()(AccRef acc, const Unit& u, int wr, int wc, int fr, int fq) const {
        const int row0 = u.pm * BM + wr * 64 + fr, col0 = u.pn * BM + wc * 32 + 8 * fq;
#pragma unroll
        for (int ai = 0; ai < 2; ++ai)
#pragma unroll
            for (int m = 0; m < 4; ++m) { const int row = row0 + ai * HALF + m * 16; bf16_t* p = O + (size_t)row * ldc + col0; float s = 0.f;
#pragma unroll
                for (int bj = 0; bj < 2; ++bj) { s += dot8(acc[ai][bj][m][0], acc[ai][bj][m][1]); *(u32x4*)(p + bj * HALF) = pack8(acc[ai][bj][m][0], acc[ai][bj][m][1]); }
                if (SS) { s += __shfl_xor(s, 16); s += __shfl_xor(s, 32); if (fq == 0) unsafeAtomicAdd(SS + row, s); } }
    }
};
template <int MODE> struct EpiScaled { static constexpr bool PERM = true; bf16_t* O; int ldc; const float* SS; float inv_n; float mul;
    __device__ __forceinline__ void operator()(AccRef acc, const Unit& u, int wr, int wc, int fr, int fq) const {
        const int row0 = u.pm * BM + wr * 64 + fr, col0 = u.pn * BM + wc * 32 + 8 * fq;
#pragma unroll
        for (int ai = 0; ai < 2; ++ai)
#pragma unroll
            for (int m = 0; m < 4; ++m) { const int row = row0 + ai * HALF + m * 16; bf16_t* p = O + (size_t)row * ldc + col0;
                float rs = 1.f; if (MODE == 1) rs = __builtin_amdgcn_rsqf(SS[row] * inv_n + EPS) * mul;
#pragma unroll
                for (int bj = 0; bj < 2; ++bj) { f32x4 v0 = acc[ai][bj][m][0], v1 = acc[ai][bj][m][1];
                    if (MODE == 1) { v0 = v0 * rs; v1 = v1 * rs; }
                    else { const f32x4 s0 = *(const f32x4*)(SS + col0 + bj * HALF), s1 = *(const f32x4*)(SS + col0 + bj * HALF + 4);
#pragma unroll
                        for (int j = 0; j < 4; ++j) { v0[j] *= __builtin_amdgcn_rsqf(s0[j] * inv_n + EPS); v1[j] *= __builtin_amdgcn_rsqf(s1[j] * inv_n + EPS); } }
                    *(u32x4*)(p + bj * HALF) = pack8(v0, v1); }
                asm volatile("" ::: "memory"); }
    }
};
struct EpiInProj { static constexpr bool PERM = true; bf16_t* O; const float* bgate; float* SSQ; float* SSKV;
    __device__ __forceinline__ void operator()(AccRef acc, const Unit& u, int wr, int wc, int fr, int fq) const {
        const int row0 = u.pm * BM + wr * 64 + fr, col0 = u.pn * BM + wc * 32 + 8 * fq;
        const bool gate = u.pn >= 7;
        f32x4 bv[2][2];
#pragma unroll
        for (int bj = 0; bj < 2; ++bj)
#pragma unroll
            for (int n = 0; n < 2; ++n) bv[bj][n] = gate ? *(const f32x4*)(bgate + (col0 - C_GATE) + bj * HALF + 4 * n) : (f32x4){0.f, 0.f, 0.f, 0.f};
        float* ss0 = (u.pn == 4 || u.pn == 5) ? SSQ : (u.pn == 6 ? SSKV : nullptr);
        float* ss1 = (u.pn == 4) ? SSQ : (u.pn == 5 ? SSKV : nullptr);
#pragma unroll
        for (int ai = 0; ai < 2; ++ai)
#pragma unroll
            for (int m = 0; m < 4; ++m) { const int row = row0 + ai * HALF + m * 16; bf16_t* p = O + (size_t)row * PROJ_LD + col0;
#pragma unroll
                for (int bj = 0; bj < 2; ++bj) { f32x4 v0 = acc[ai][bj][m][0], v1 = acc[ai][bj][m][1];
                    float* ss = bj ? ss1 : ss0;
                    if (ss) { float s = dot8(v0, v1); s += __shfl_xor(s, 16); s += __shfl_xor(s, 32); if (fq == 0) unsafeAtomicAdd(ss + row, s); }
                    if (gate) {
#pragma unroll
                        for (int j = 0; j < 4; ++j) { v0[j] = sigmoidf_(v0[j] + bv[bj][0][j]); v1[j] = sigmoidf_(v1[j] + bv[bj][1][j]); } }
                    *(u32x4*)(p + bj * HALF) = pack8(v0, v1); } }
    }
};
template <int BR> struct EpiMix { static constexpr bool PERM = true; bf16_t* MIX; const bf16_t* PROJ;
    __device__ __forceinline__ void operator()(AccRef acc, const Unit& u, int wr, int wc, int fr, int fq) const {
        const int row0 = u.pm * BM + wr * 64 + fr, col0 = u.pn * BM + wc * 32 + 8 * fq;
#pragma unroll
        for (int ai = 0; ai < 2; ++ai)
#pragma unroll
            for (int m = 0; m < 4; ++m) { const int row = row0 + ai * HALF + m * 16; bf16_t* p = MIX + (size_t)row * D + col0; const bf16_t* gp = PROJ + (size_t)row * PROJ_LD + C_GATE + BR * 1024 + col0;
#pragma unroll
                for (int bj = 0; bj < 2; ++bj) { const u32x4 gw = *(const u32x4*)(gp + bj * HALF);
                    f32x4 g0 = {bf_lo(gw.x), bf_hi(gw.x), bf_lo(gw.y), bf_hi(gw.y)}, g1 = {bf_lo(gw.z), bf_hi(gw.z), bf_lo(gw.w), bf_hi(gw.w)};
                    f32x4 v0 = acc[ai][bj][m][0] * g0, v1 = acc[ai][bj][m][1] * g1;
                    if (BR == 1) { const u32x4 pw = *(const u32x4*)(p + bj * HALF);
                        v0 = v0 + (f32x4){bf_lo(pw.x), bf_hi(pw.x), bf_lo(pw.y), bf_hi(pw.y)}; v1 = v1 + (f32x4){bf_lo(pw.z), bf_hi(pw.z), bf_lo(pw.w), bf_hi(pw.w)}; }
                    *(u32x4*)(p + bj * HALF) = pack8(v0, v1); } }
    }
};
}

constexpr int NWAVES = 8, NTHREADS = 512;
constexpr int LDS_BYTES = 147456;

struct Frame {
    LAS unsigned char* lds;
    int tid, lane, wave, G, bid;
    unsigned char* ws;
    const float* const* in;
    float* out;
};

__device__ __forceinline__ void p0_transpose_item(const float* W, int ldw, bf16_t* dst, int dst_ld, int k0, int n0, const float* gain, LAS float* scr, int lane) {
#pragma unroll 8
    for (int i = 0; i < 32; ++i) { const int kk = 2 * i + (lane >> 5); float v = W[(size_t)(k0 + kk) * ldw + n0 + (lane & 31)]; if (gain) v *= gain[k0 + kk]; scr[kk * 33 + (lane & 31)] = v; }
    asm volatile("s_waitcnt lgkmcnt(0)" ::: "memory");
    const int c = lane & 7;
#pragma unroll
    for (int j = 0; j < 4; ++j) { const int n = (lane >> 3) + 8 * j; const LAS float* s = scr + (8 * c) * 33 + n;
        u32x4 o; o.x = cvt_pk_bf16(s[0 * 33], s[1 * 33]); o.y = cvt_pk_bf16(s[2 * 33], s[3 * 33]); o.z = cvt_pk_bf16(s[4 * 33], s[5 * 33]); o.w = cvt_pk_bf16(s[6 * 33], s[7 * 33]);
        *(u32x4*)(dst + (size_t)n * dst_ld + k0 + 8 * c) = o; }
    asm volatile("s_waitcnt lgkmcnt(0)" ::: "memory");
}
struct TMat { int idx, K, N, mode; size_t dst; int gain_idx; };
__device__ __forceinline__ void p0_transposes(const Frame& F) {
    LAS float* scr = (LAS float*)(F.lds + F.wave * 16384);
    const int gw = F.bid * NWAVES + F.wave, NGW = F.G * NWAVES;
    const TMat tm[12] = {
        {3, 1024, 2816, 1, W_GU1, -1}, {4, 1024, 2816, 2, W_GU1, -1}, {5, 2816, 1024, 0, W_D1, -1},
        {19, 1024, 2816, 1, W_GU2, -1}, {20, 1024, 2816, 2, W_GU2, -1}, {21, 2816, 1024, 0, W_D2, -1},
        {8, 1024, 4256, 3, W_IN, -1}, {11, 384, 768, 0, W_UQ, 10}, {13, 256, 1024, 4, W_UKVK, 12},
        {14, 512, 1024, 0, W_SBO, -1}, {15, 512, 1024, 0, W_MLAO, -1}, {16, 1024, 1024, 0, W_OUT, -1}};
    int base = 0;
#pragma unroll 1
    for (int mi = 0; mi < 12; ++mi) {
        const int K = tm[mi].K, N = tm[mi].N, mode = tm[mi].mode, nblk = N / 32, nitems = (K / 64) * nblk;
        const float* W = F.in[tm[mi].idx]; const float* gain = tm[mi].gain_idx >= 0 ? F.in[tm[mi].gain_idx] : nullptr;
        int it = ((gw - base) % NGW + NGW) % NGW;
        for (; it < nitems; it += NGW) {
            const int kb = it / nblk, nb = it % nblk, k0 = 64 * kb, n0 = 32 * nb;
            bf16_t* dst = (bf16_t*)(F.ws + tm[mi].dst); int drow = n0;
            if (mode == 1) drow = 256 * (n0 >> 7) + (n0 & 127);
            else if (mode == 2) drow = 256 * (n0 >> 7) + 128 + (n0 & 127);
            else if (mode == 3) {
                if (n0 < 1024) drow = n0;
                else if (n0 < 1536) { dst = (bf16_t*)(F.ws + W_SBV); drow = n0 - 1024; }
                else if (n0 < 2208) drow = n0 - 1536 + C_CQ;
                else drow = n0 - 2208 + C_GATE;
            } else if (mode == 4) { const int hd = n0 >> 7, e = n0 & 127;
                if (e < 64) drow = hd * 64 + e; else { dst = (bf16_t*)(F.ws + W_UKVV); drow = hd * 64 + (e - 64); } }
            p0_transpose_item(W, N, dst + (size_t)drow * K, K, k0, n0, gain, scr, F.lane);
        }
        base = (base + nitems) % NGW;
    }
}

template <int MODE>
__device__ __forceinline__ void norm_rows(const Frame& F, const float* SS, float coef, const float* gpost, const float* gpre) {
    const int gw = F.bid * NWAVES + F.wave, NGW = F.G * NWAVES, lane = F.lane;
    const bf16_t* Fb = (const bf16_t*)(F.ws + WS_B); bf16_t* XN = (bf16_t*)(F.ws + WS_A); float* HM = (float*)(F.ws + WS_HM);
    const int rows = (MODE >= 2) ? MX : MT;
    for (int row = gw; row < rows; row += NGW) {
        const float* src; float* hdst = row < MX ? F.out + (size_t)row * D : HM + (size_t)(row - MX) * D;
        if (MODE <= 1) src = row < MX ? F.in[0] + (size_t)row * D : F.in[1] + (size_t)((row - MX) & 15) * D; else src = hdst;
        f32x4 v[4];
#pragma unroll
        for (int j = 0; j < 4; ++j) v[j] = *(const f32x4*)(src + 256 * j + 4 * lane);
        if (MODE >= 1) {
            const float rs = __builtin_amdgcn_rsqf(SS[row] * (1.0f / D) + EPS) * coef;
#pragma unroll
            for (int j = 0; j < 4; ++j) { const u32x2 fw = *(const u32x2*)(Fb + (size_t)row * D + 256 * j + 4 * lane); const f32x4 gp = *(const f32x4*)(gpost + 256 * j + 4 * lane);
                const f32x4 fv = {bf_lo(fw.x), bf_hi(fw.x), bf_lo(fw.y), bf_hi(fw.y)};
                v[j] = v[j] + fv * rs * gp; }
#pragma unroll
            for (int j = 0; j < 4; ++j) *(f32x4*)(hdst + 256 * j + 4 * lane) = v[j];
        }
        if (MODE != 3) {
            float s = 0.f;
#pragma unroll
            for (int j = 0; j < 4; ++j) s += (v[j][0] * v[j][0] + v[j][1] * v[j][1]) + (v[j][2] * v[j][2] + v[j][3] * v[j][3]);
            const float r2 = __builtin_amdgcn_rsqf(wave_sum(s) * (1.0f / D) + EPS);
#pragma unroll
            for (int j = 0; j < 4; ++j) { const f32x4 gp = *(const f32x4*)(gpre + 256 * j + 4 * lane); const f32x4 o = v[j] * r2 * gp;
                u32x2 w; w.x = cvt_pk_bf16(o[0], o[1]); w.y = cvt_pk_bf16(o[2], o[3]); *(u32x2*)(XN + (size_t)row * D + 256 * j + 4 * lane) = w; }
        }
    }
}

constexpr int KROW = 208, VROW = 136;
constexpr int KBUF = 64 * KROW, VBUF = 64 * VROW;
constexpr int ATT_K = 0, ATT_V = 2 * KBUF, ATT_MISC = ATT_V + 2 * VBUF;
#define MFMA32(a, b, c) __builtin_amdgcn_mfma_f32_32x32x16_bf16((a), (b), (c), 0, 0, 0)

struct TileRegs { u32x4 k; u32x4 kr; u32x4 v; };

template <bool MLA>
__device__ __forceinline__ void attn_unit(const Frame& F, int b, int hd, int qb) {
    const int tid = F.tid, lane = F.lane, w = F.wave, r = lane & 31, hh = lane >> 5;
    unsigned char* ws = F.ws;
    const bf16_t* PROJ = (const bf16_t*)(ws + WS_P);
    const bf16_t* KN = (const bf16_t*)(ws + WS_A); const bf16_t* KROPE = KN + (size_t)MT * 512;
    const bf16_t* VT = (const bf16_t*)(ws + WS_B) + (MLA ? (size_t)512 * LDVT : 0);
    const bf16_t* QALL = (const bf16_t*)(ws + WS_C); bf16_t* YM = (bf16_t*)(ws + WS_YM);
    const float* TAB = (const float*)(ws + WS_TAB);
    LAS unsigned char* lds = F.lds;
    const int q0 = qb * 256, qw0 = q0 + 32 * w, tq = qw0 + r;
    const size_t rq = (size_t)b * SEQ + tq;
    constexpr int NKS = MLA ? 6 : 4;
    bf16x8 qf[NKS];
    if (MLA) {
#pragma unroll
        for (int d0 = 0; d0 < 4; ++d0) qf[d0] = *(const bf16x8*)(QALL + rq * 768 + hd * 96 + 16 * d0 + 8 * hh);
        const u32x4 x1w = *(const u32x4*)(QALL + rq * 768 + hd * 96 + 64 + 8 * hh), x2w = *(const u32x4*)(QALL + rq * 768 + hd * 96 + 80 + 8 * hh);
        const float* tp = TAB + ((size_t)(NMETA + tq) * 16 + 8 * hh) * 2;
        u32x4 r1, r2;
#pragma unroll
        for (int jj = 0; jj < 4; ++jj) { const f32x4 cs = *(const f32x4*)(tp + 4 * jj);
            const float a0 = bf_lo(x1w[jj]), a1 = bf_hi(x1w[jj]), b0 = bf_lo(x2w[jj]), b1 = bf_hi(x2w[jj]);
            r1[jj] = cvt_pk_bf16(a0 * cs[0] - b0 * cs[1], a1 * cs[2] - b1 * cs[3]);
            r2[jj] = cvt_pk_bf16(a0 * cs[1] + b0 * cs[0], a1 * cs[3] + b1 * cs[2]); }
        qf[4] = __builtin_bit_cast(bf16x8, r1); qf[5] = __builtin_bit_cast(bf16x8, r2);
    } else {
#pragma unroll
        for (int d0 = 0; d0 < 4; ++d0) qf[d0] = *(const bf16x8*)(PROJ + rq * PROJ_LD + C_SBQ + hd * 64 + 16 * d0 + 8 * hh);
    }
    const int NT = 4 * qb + 5;
    const int kt_d = qw0 >> 6;
    const int lrow = tid >> 3, lch = tid & 7;
    auto load_tile = [&](int it, TileRegs& T) {
        const bool meta = (it == NT - 1); const int kt = 4 * qb + 3 - it;
        const u32x4 z = {0u, 0u, 0u, 0u};
        const size_t krow = meta ? (size_t)MX + lrow : (size_t)b * SEQ + 64 * kt + lrow;
        const bool kvalid = !meta || lrow < 16;
        if (MLA) { T.k = kvalid ? *(const u32x4*)(KN + krow * 512 + hd * 64 + lch * 8) : z;
            if (tid < 256) { const int rr = tid >> 2, cc = tid & 3; const size_t kr2 = meta ? (size_t)MX + rr : (size_t)b * SEQ + 64 * kt + rr;
                T.kr = (!meta || rr < 16) ? *(const u32x4*)(KROPE + kr2 * 32 + cc * 8) : z; }
        } else T.k = kvalid ? *(const u32x4*)(PROJ + krow * PROJ_LD + C_SBK + hd * 64 + lch * 8) : z;
        const size_t vcol = meta ? (size_t)MX + lch * 8 : (size_t)b * SEQ + 64 * kt + lch * 8;
        T.v = (!meta || lch < 2) ? *(const u32x4*)(VT + (size_t)(hd * 64 + lrow) * LDVT + vcol) : z;
    };
    auto store_tile = [&](int buf, const TileRegs& T) {
        *(LAS u32x4*)(lds + ATT_K + buf * KBUF + lrow * KROW + lch * 16) = T.k;
        if (MLA) { if (tid < 256) *(LAS u32x4*)(lds + ATT_K + buf * KBUF + (tid >> 2) * KROW + 128 + (tid & 3) * 16) = T.kr; }
        LAS unsigned char* vp = lds + ATT_V + buf * VBUF + lrow * VROW + lch * 16;
        *(LAS u32x2*)vp = (u32x2){T.v.x, T.v.y}; *(LAS u32x2*)(vp + 8) = (u32x2){T.v.z, T.v.w};
    };
    f32x16 o0, o1;
#pragma unroll
    for (int i = 0; i < 16; ++i) { o0[i] = 0.f; o1[i] = 0.f; }
    float R = 1.0f;
    float mrun = -1e30f, lrun = 0.f;
    TileRegs T; T.kr = (u32x4){0u, 0u, 0u, 0u};
    load_tile(0, T); store_tile(0, T);
    __syncthreads();
    for (int it = 0; it < NT; ++it) {
        const int cur = it & 1; const bool meta = (it == NT - 1); const int kt = 4 * qb + 3 - it;
        if (it + 1 < NT) load_tile(it + 1, T);
        const bool active = meta || kt <= kt_d;
        if (active) {
            f32x16 p0, p1;
#pragma unroll
            for (int i = 0; i < 16; ++i) { p0[i] = 0.f; p1[i] = 0.f; }
            const LAS unsigned char* kb = lds + ATT_K + cur * KBUF + r * KROW + hh * 16;
#pragma unroll
            for (int d0 = 0; d0 < NKS; ++d0) { const bf16x8 k0 = *(const LAS bf16x8*)(kb + d0 * 32), k1 = *(const LAS bf16x8*)(kb + 32 * KROW + d0 * 32);
                p0 = MFMA32(k0, qf[d0], p0); p1 = MFMA32(k1, qf[d0], p1); }
            if (MLA) {
                if (meta) {
#pragma unroll
                    for (int i = 0; i < 16; ++i) { const int kk = 8 * (i >> 2) + 4 * hh + (i & 3); if (kk >= 16) p0[i] = -1e30f; p1[i] = -1e30f; }
                }
                float mx = p0[0];
#pragma unroll
                for (int i = 1; i < 16; ++i) mx = fmaxf(mx, p0[i]);
#pragma unroll
                for (int i = 0; i < 16; ++i) mx = fmaxf(mx, p1[i]);
                mx = fmaxf(mx, __shfl_xor(mx, 32));
                const float mnew = fmaxf(mrun, mx), fsc = fexp2(mrun - mnew); mrun = mnew; lrun *= fsc;
#pragma unroll
                for (int i = 0; i < 16; ++i) { o0[i] *= fsc; o1[i] *= fsc; }
                float ls = 0.f;
#pragma unroll
                for (int i = 0; i < 16; ++i) { p0[i] = fexp2(p0[i] - mnew); p1[i] = fexp2(p1[i] - mnew); ls += p0[i] + p1[i]; }
                lrun += ls;
            } else {
                const int lim = meta ? 16 : (kt == kt_d ? tq - 64 * kt : 64);
                f32x16 m0, m1;
#pragma unroll
                for (int i = 0; i < 16; ++i) { const int kk = 8 * (i >> 2) + 4 * hh + (i & 3);
                    { const float s = p0[i], e = fexp2(-fabsf(s) * SB_C), d = frcp(1.0f + e), sm = e * d; const bool ps = s > 0.f, vl = kk < lim;
                      p0[i] = vl ? (ps ? d : sm) : 0.f; m0[i] = vl ? (ps ? sm : d) : 1.f; }
                    { const float s = p1[i], e = fexp2(-fabsf(s) * SB_C), d = frcp(1.0f + e), sm = e * d; const bool ps = s > 0.f, vl = (kk + 32) < lim;
                      p1[i] = vl ? (ps ? d : sm) : 0.f; m1[i] = vl ? (ps ? sm : d) : 1.f; } }
                float Pr = R;
#define SB_GROUP(PV, MV, G4) do { const float oa = MV[G4], ob = MV[G4 + 1], oc = MV[G4 + 2], od = MV[G4 + 3]; const float Tm = (oa * ob) * (oc * od), To = __shfl_xor(Tm, 32); \
                    float pre = hh ? Pr : Pr * To; Pr = Pr * (Tm * To); PV[G4 + 3] *= pre; pre *= od; PV[G4 + 2] *= pre; pre *= oc; PV[G4 + 1] *= pre; pre *= ob; PV[G4] *= pre; } while (0)
                SB_GROUP(p1, m1, 12); SB_GROUP(p1, m1, 8); SB_GROUP(p1, m1, 4); SB_GROUP(p1, m1, 0);
                SB_GROUP(p0, m0, 12); SB_GROUP(p0, m0, 8); SB_GROUP(p0, m0, 4); SB_GROUP(p0, m0, 0);
#undef SB_GROUP
                R = Pr;
            }
            bf16x8 pa[4];
            { u32x4 t;
              t.x = cvt_pk_bf16(p0[0], p0[1]); t.y = cvt_pk_bf16(p0[2], p0[3]); t.z = cvt_pk_bf16(p0[4], p0[5]); t.w = cvt_pk_bf16(p0[6], p0[7]); pa[0] = __builtin_bit_cast(bf16x8, t);
              t.x = cvt_pk_bf16(p0[8], p0[9]); t.y = cvt_pk_bf16(p0[10], p0[11]); t.z = cvt_pk_bf16(p0[12], p0[13]); t.w = cvt_pk_bf16(p0[14], p0[15]); pa[1] = __builtin_bit_cast(bf16x8, t);
              t.x = cvt_pk_bf16(p1[0], p1[1]); t.y = cvt_pk_bf16(p1[2], p1[3]); t.z = cvt_pk_bf16(p1[4], p1[5]); t.w = cvt_pk_bf16(p1[6], p1[7]); pa[2] = __builtin_bit_cast(bf16x8, t);
              t.x = cvt_pk_bf16(p1[8], p1[9]); t.y = cvt_pk_bf16(p1[10], p1[11]); t.z = cvt_pk_bf16(p1[12], p1[13]); t.w = cvt_pk_bf16(p1[14], p1[15]); pa[3] = __builtin_bit_cast(bf16x8, t); }
            const LAS unsigned char* vb = lds + ATT_V + cur * VBUF + r * VROW + hh * 8;
#pragma unroll
            for (int s = 0; s < 4; ++s) {
                const s16x4 a0 = *(const LAS s16x4*)(vb + s * 32), a1 = *(const LAS s16x4*)(vb + s * 32 + 16);
                const s16x4 c0 = *(const LAS s16x4*)(vb + 32 * VROW + s * 32), c1 = *(const LAS s16x4*)(vb + 32 * VROW + s * 32 + 16);
                const bf16x8 vf0 = __builtin_shufflevector(a0, a1, 0, 1, 2, 3, 4, 5, 6, 7), vf1 = __builtin_shufflevector(c0, c1, 0, 1, 2, 3, 4, 5, 6, 7);
                o0 = MFMA32(vf0, pa[s], o0); o1 = MFMA32(vf1, pa[s], o1);
            }
        }
        if (it + 1 < NT) store_tile(cur ^ 1, T);
        if (MLA) __syncthreads();
        else {
            const int wdone = (active && __all(R < 1e-30f)) ? 1 : 0;
            if (__syncthreads_and(wdone)) break;
        }
    }
    float inv = 1.0f;
    if (MLA) { const float lt = lrun + __shfl_xor(lrun, 32); inv = 1.0f / lt; }
    bf16_t* yrow = MLA ? YM + rq * 512 + hd * 64 : (bf16_t*)(ws + WS_P) + rq * PROJ_LD + C_SBQ + hd * 64;
#pragma unroll
    for (int g = 0; g < 4; ++g) {
        u32x2 w0, w1;
        w0.x = cvt_pk_bf16(o0[4 * g] * inv, o0[4 * g + 1] * inv); w0.y = cvt_pk_bf16(o0[4 * g + 2] * inv, o0[4 * g + 3] * inv);
        w1.x = cvt_pk_bf16(o1[4 * g] * inv, o1[4 * g + 1] * inv); w1.y = cvt_pk_bf16(o1[4 * g + 2] * inv, o1[4 * g + 3] * inv);
        *(u32x2*)(yrow + 8 * g + 4 * hh) = w0; *(u32x2*)(yrow + 32 + 8 * g + 4 * hh) = w1;
    }
    __syncthreads();
}

__device__ __forceinline__ void attn_phase(const Frame& F) {
    unsigned* ctr = (unsigned*)(F.ws + WS_CTL);
    LAS unsigned* slot = (LAS unsigned*)(F.lds + ATT_MISC);
    for (;;) {
        if (F.tid == 0) *slot = atomicAdd(ctr, 1u);
        __syncthreads();
        const unsigned u = *slot;
        __syncthreads();
        if (u >= 2048u) break;
        const int uu = (int)(u & 1023u), qb = 7 - (uu >> 7), bh = uu & 127;
        if (u < 1024u) attn_unit<true>(F, bh >> 3, bh & 7, qb); else attn_unit<false>(F, bh >> 3, bh & 7, qb);
    }
}

__global__ void __launch_bounds__(NTHREADS, 2) fwd_kernel(Params P) {
    extern __shared__ __attribute__((aligned(16))) unsigned char lds_raw[];
#define MKFRAME() Frame F; { int t_ = threadIdx.x; asm volatile("" : "+v"(t_)); F.lds = (LAS unsigned char*)lds_raw; F.tid = t_; F.lane = t_ & 63; F.wave = __builtin_amdgcn_readfirstlane(t_ >> 6); \
        F.G = gridDim.x; F.bid = blockIdx.x; F.ws = P.ws; F.in = P.in; F.out = P.out; } const int gtid = F.bid * NTHREADS + F.tid, GT = F.G * NTHREADS; (void)gtid; (void)GT
    unsigned char* ws = P.ws;
    const int lo = P.ph_lo, hi = P.ph_hi;
#ifndef PHMASK
#define PHMASK 0x1fff
#endif
#define IN(k) (((PHMASK >> (k)) & 1) && lo <= (k) && (k) < hi)
#define SEAM(k) do { if (IN(k) && IN((k) + 1)) { asm volatile("s_waitcnt vmcnt(0) lgkmcnt(0)" ::: "memory"); cg::this_grid().sync(); } } while (0)
    float* SS1 = (float*)(ws + WS_SS); float* SS2 = SS1 + MT; float* SS3 = SS2 + MT; float* SSQ = SS3 + MT; float* SSKV = SSQ + MT;
    float* TAB = (float*)(ws + WS_TAB);
    bf16_t* XN = (bf16_t*)(ws + WS_A); bf16_t* FB = (bf16_t*)(ws + WS_B); bf16_t* PROJ = (bf16_t*)(ws + WS_P); bf16_t* HID = PROJ;
    bf16_t* KN = XN; bf16_t* KROPE = KN + (size_t)MT * 512; bf16_t* MIX = XN;
    bf16_t* VTSB = FB; bf16_t* VTMLA = FB + (size_t)512 * LDVT;
    bf16_t* QALL = (bf16_t*)(ws + WS_C); bf16_t* YM = (bf16_t*)(ws + WS_YM);

    if (IN(0)) { MKFRAME();
        p0_transposes(F);
        for (int i = gtid; i < 5 * MT; i += GT) SS1[i] = 0.f;
        if (gtid == 0) *(unsigned*)(ws + WS_CTL) = 0u;
        for (int i = gtid; i < 2064 * 16; i += GT) { const int pos = i >> 4, j = i & 15; const float ang = (float)pos * P.inv_freq[j];
            const double rev = (double)ang * 0.15915494309189535; const float fr = (float)(rev - __builtin_rint(rev));
            TAB[2 * i] = __builtin_amdgcn_cosf(fr); TAB[2 * i + 1] = __builtin_amdgcn_sinf(fr); }
        norm_rows<0>(F, nullptr, 0.f, nullptr, P.in[2]);
    }
    SEAM(0);
    if (IN(1)) { MKFRAME(); pg8::Gemm g{XN, (const bf16_t*)(ws + W_GU1), MT, 5632, 1024, 1024, 1024}; pg8::StaticOrder S; S.init(MT, 5632, F.G, F.bid);
        pg8::EpiSwiglu E{HID}; pg8::gemm_phase(F.lds, g, S, E); }
    SEAM(1);
    if (IN(2)) { MKFRAME(); pg8::Gemm g{HID, (const bf16_t*)(ws + W_D1), MT, 1024, 2816, 2816, 2816}; pg8::StaticOrder S; S.init(MT, 1024, F.G, F.bid);
        pg8::EpiStoreSS E{FB, D, SS1}; pg8::gemm_phase(F.lds, g, S, E); }
    SEAM(2);
    if (IN(3)) { MKFRAME(); norm_rows<1>(F, SS1, 0.5f, P.in[6], P.in[7]); }
    SEAM(3);
    if (IN(4)) { MKFRAME();
        { pg8::Gemm g{XN, (const bf16_t*)(ws + W_IN), MT, PROJ_LD, 1024, 1024, 1024}; pg8::StaticOrder S; S.init(MT, PROJ_LD, F.G, F.bid);
          pg8::EpiInProj E{PROJ, P.in[9], SSQ, SSKV}; pg8::gemm_phase(F.lds, g, S, E); }
        { pg8::Gemm g{(const bf16_t*)(ws + W_SBV), XN, 512, MT, 1024, 1024, 1024}; pg8::StaticOrder S; S.init(512, MT, F.G, (F.bid + 128) & 255);
          pg8::EpiStoreSS E{VTSB, LDVT, nullptr}; pg8::gemm_phase(F.lds, g, S, E); }
    }
    SEAM(4);
    if (IN(5)) { MKFRAME();
        for (int i = gtid; i < MT * 16; i += GT) { const int row = i >> 4, j = i & 15; const int pos = row_pos(row);
            const float c = TAB[(pos * 16 + j) * 2], s = TAB[(pos * 16 + j) * 2 + 1];
            const float x1 = __uint_as_float((unsigned)PROJ[(size_t)row * PROJ_LD + C_KR + j] << 16), x2 = __uint_as_float((unsigned)PROJ[(size_t)row * PROJ_LD + C_KR + 16 + j] << 16);
            const unsigned a = cvt_pk_bf16(x1 * c - x2 * s, x1 * s + x2 * c);
            KROPE[(size_t)row * 32 + j] = (bf16_t)(a & 0xffffu); KROPE[(size_t)row * 32 + 16 + j] = (bf16_t)(a >> 16); }
#ifndef P5SUB
#define P5SUB 7
#endif
        if (P5SUB & 1) { pg8::Gemm g{PROJ + C_CQ, (const bf16_t*)(ws + W_UQ), MX, 768, 384, PROJ_LD, 384}; pg8::StaticOrder S; S.init(MX, 768, F.G, F.bid);
          pg8::EpiScaled<1> E{QALL, 768, SSQ, 1.0f / 384.0f, MLA_QSCALE}; pg8::gemm_phase(F.lds, g, S, E); }
        if (P5SUB & 2) { pg8::Gemm g{PROJ + C_CKV, (const bf16_t*)(ws + W_UKVK), MT, 512, 256, PROJ_LD, 256}; pg8::StaticOrder S; S.init(MT, 512, F.G, (F.bid + 120) & 255);
          pg8::EpiScaled<1> E{KN, 512, SSKV, 1.0f / 256.0f, 1.0f}; pg8::gemm_phase(F.lds, g, S, E); }
        if (P5SUB & 4) { pg8::Gemm g{(const bf16_t*)(ws + W_UKVV), PROJ + C_CKV, 512, MT, 256, 256, PROJ_LD}; pg8::StaticOrder S; S.init(512, MT, F.G, (F.bid + 112) & 255);
          pg8::EpiScaled<2> E{VTMLA, LDVT, SSKV, 1.0f / 256.0f, 1.0f}; pg8::gemm_phase(F.lds, g, S, E); }
    }
    SEAM(5);
    if (IN(6)) { MKFRAME(); attn_phase(F); }
    SEAM(6);
    if (IN(7)) { MKFRAME();
        { pg8::Gemm g{PROJ + C_SBQ, (const bf16_t*)(ws + W_SBO), MX, 1024, 512, PROJ_LD, 512}; pg8::StaticOrder S; S.init(MX, 1024, F.G, F.bid);
          pg8::EpiMix<0> E{MIX, PROJ}; pg8::gemm_phase(F.lds, g, S, E); }
        { pg8::Gemm g{YM, (const bf16_t*)(ws + W_MLAO), MX, 1024, 512, 512, 512}; pg8::StaticOrder S; S.init(MX, 1024, F.G, F.bid);
          pg8::EpiMix<1> E{MIX, PROJ}; pg8::gemm_phase(F.lds, g, S, E); }
    }
    SEAM(7);
    if (IN(8)) { MKFRAME(); pg8::Gemm g{MIX, (const bf16_t*)(ws + W_OUT), MX, 1024, 1024, 1024, 1024}; pg8::StaticOrder S; S.init(MX, 1024, F.G, F.bid);
        pg8::EpiStoreSS E{FB, D, SS2}; pg8::gemm_phase(F.lds, g, S, E); }
    SEAM(8);
    if (IN(9)) { MKFRAME(); norm_rows<2>(F, SS2, 1.0f, P.in[17], P.in[18]); }
    SEAM(9);
    if (IN(10)) { MKFRAME(); pg8::Gemm g{XN, (const bf16_t*)(ws + W_GU2), MX, 5632, 1024, 1024, 1024}; pg8::StaticOrder S; S.init(MX, 5632, F.G, F.bid);
        pg8::EpiSwiglu E{HID}; pg8::gemm_phase(F.lds, g, S, E); }
    SEAM(10);
    if (IN(11)) { MKFRAME(); pg8::Gemm g{HID, (const bf16_t*)(ws + W_D2), MX, 1024, 2816, 2816, 2816}; pg8::StaticOrder S; S.init(MX, 1024, F.G, F.bid);
        pg8::EpiStoreSS E{FB, D, SS3}; pg8::gemm_phase(F.lds, g, S, E); }
    SEAM(11);
    if (IN(12)) { MKFRAME(); norm_rows<3>(F, SS3, 0.5f, P.in[22], nullptr); }
#undef IN
#undef SEAM
}

extern "C" void kernel_launch(void* const* d_in, const int* in_sizes, int n_in, void* d_out, int out_size, void* d_ws, size_t ws_size, hipStream_t stream) {
    static int grid = 0;
    if (grid == 0) {
        if (n_in != 23 || out_size != MX * D || ws_size < WS_END) { fprintf(stderr, "kernel_launch: unexpected shapes (n_in %d out %d ws %zu)\n", n_in, out_size, ws_size); grid = -1; return; }
        if (hipFuncSetAttribute((const void*)fwd_kernel, hipFuncAttributeMaxDynamicSharedMemorySize, LDS_BYTES) != hipSuccess) { fprintf(stderr, "kernel_launch: hipFuncSetAttribute failed\n"); grid = -1; return; }
        int dev = 0, cus = 0, per_cu = 0;
        (void)hipGetDevice(&dev); (void)hipDeviceGetAttribute(&cus, hipDeviceAttributeMultiprocessorCount, dev);
        (void)hipOccupancyMaxActiveBlocksPerMultiprocessor(&per_cu, (const void*)fwd_kernel, NTHREADS, LDS_BYTES);
        if (per_cu < 1) fprintf(stderr, "kernel_launch: occupancy query says %d blocks/CU\n", per_cu);
        (void)hipGetLastError();
        grid = cus > 0 ? cus : 256;
    }
    if (grid < 0) return;
    Params p{};
    for (int i = 0; i < 23; ++i) p.in[i] = (const float*)d_in[i];
    p.out = (float*)d_out; p.ws = (unsigned char*)d_ws;
    for (int j = 0; j < 16; ++j) p.inv_freq[j] = powf(10000.0f, -(float)j / 16.0f);
#if ONE_LAUNCH
    p.ph_lo = 0; p.ph_hi = 13;
    void* args[] = {&p};
    hipError_t e = hipLaunchCooperativeKernel((const void*)fwd_kernel, dim3(grid), dim3(NTHREADS), args, LDS_BYTES, stream);
    if (e != hipSuccess) fprintf(stderr, "kernel_launch: cooperative launch failed: %s (grid %d)\n", hipGetErrorString(e), grid);
#else
    for (int ph = 0; ph < 13; ++ph) { p.ph_lo = ph; p.ph_hi = ph + 1; hipLaunchKernelGGL(fwd_kernel, dim3(grid), dim3(NTHREADS), LDS_BYTES, stream, p); }
#endif
}
```
